# Optimizing an MI355X kernel written in HIP

```python
import math
import jax, jax.numpy as jnp
from jax import lax
import numpy as np

D_MODEL = 2048
BATCH = 2
SEQ = 8192
DEPTH = 4

N_FOURIER_GROUPS = 4
FOURIER_GROUP_DIM = D_MODEL // 8
D_FOURIER = N_FOURIER_GROUPS * FOURIER_GROUP_DIM
N_HEADS = 8
QK_HEAD_DIM = D_MODEL // 32
V_HEAD_DIM = 2 * QK_HEAD_DIM
D_QK = N_HEADS * 2 * QK_HEAD_DIM
D_V = N_HEADS * V_HEAD_DIM
ROPE_DIM = QK_HEAD_DIM // 4
ROPE_THETA = 500000.0
D_FF = ((8 * D_MODEL // 3 + 255) // 256) * 256
D_IN = D_FOURIER + 2 * D_QK + D_V + 2 * D_MODEL
Q_BLOCK = 128
EPS = 1e-6
LAMBDA_STD = 0.1

kernel_name = 'hybrid_fourier_diffattn_macaron_encoder'


def rms_norm(x, g):
    xf = x.astype(jnp.float32)
    y = xf * lax.rsqrt(jnp.mean(xf * xf, axis=-1, keepdims=True) + EPS)
    return (y * g.astype(jnp.float32)).astype(x.dtype)


def swiglu(h, w_gate, w_up, w_down):
    return (jax.nn.silu(h @ w_gate) * (h @ w_up)) @ w_down


def rope_tables(s):
    pos = jnp.arange(s, dtype=jnp.float32)
    inv_freq = ROPE_THETA ** (-jnp.arange(0, ROPE_DIM, 2, dtype=jnp.float32) / ROPE_DIM)
    ang = pos[:, None] * inv_freq[None, :]
    return jnp.cos(ang)[None, :, None, None, :], jnp.sin(ang)[None, :, None, None, :]


def partial_rope(x, cos, sin):
    half = ROPE_DIM // 2
    xr = x[..., :ROPE_DIM].astype(jnp.float32)
    x1, x2 = xr[..., :half], xr[..., half:]
    rot = jnp.concatenate([x1 * cos - x2 * sin, x2 * cos + x1 * sin], axis=-1)
    return jnp.concatenate([rot.astype(x.dtype), x[..., ROPE_DIM:]], axis=-1)


def fourier_mix(u):
    b, s, _ = u.shape
    ug = u.reshape(b, s, N_FOURIER_GROUPS, FOURIER_GROUP_DIM).astype(jnp.float32)
    f = jnp.fft.fft2(ug, axes=(1, 3), norm='ortho').real
    return f.reshape(b, s, D_FOURIER).astype(u.dtype)


def diff_attention(q, k, v, lam):
    b, s = q.shape[0], q.shape[1]
    nb = s // Q_BLOCK
    scale = QK_HEAD_DIM ** -0.5
    qb = jnp.moveaxis(q.reshape(b, nb, Q_BLOCK, N_HEADS, 2, QK_HEAD_DIM), 1, 0)

    def block(qi):
        sc = jnp.einsum('bqhcd,bkhcd->bhcqk', qi, k, preferred_element_type=jnp.float32) * scale
        p = jax.nn.softmax(sc, axis=-1)
        w = p[:, :, 0] - lam * p[:, :, 1]
        return jnp.einsum('bhqk,bkhe->bqhe', w.astype(v.dtype), v)

    o = lax.map(block, qb)
    return jnp.moveaxis(o, 0, 1).reshape(b, s, N_HEADS, V_HEAD_DIM)


def setup_inputs(seed: int = 0) -> dict:
    key = jax.random.key(seed)
    ks = jax.random.split(key, 24)

    def w(k, shape, fan_in):
        return jax.random.normal(k, shape, jnp.float32) * (fan_in ** -0.5)

    def gain(k, n):
        return 1.0 + 0.02 * jax.random.normal(k, (DEPTH, n), jnp.float32)

    return {
        'x': jax.random.normal(ks[0], (BATCH, SEQ, D_MODEL), jnp.float32),
        'norm_ffa': gain(ks[1], D_MODEL),
        'ffa_gate': w(ks[2], (DEPTH, D_MODEL, D_FF), D_MODEL),
        'ffa_up': w(ks[3], (DEPTH, D_MODEL, D_FF), D_MODEL),
        'ffa_down': w(ks[4], (DEPTH, D_FF, D_MODEL), D_FF),
        'norm_mix': gain(ks[5], D_MODEL),
        'w_in': w(ks[6], (DEPTH, D_MODEL, D_IN), D_MODEL),
        'q_norm': gain(ks[7], QK_HEAD_DIM),
        'k_norm': gain(ks[8], QK_HEAD_DIM),
        'lambda_q1': LAMBDA_STD * jax.random.normal(ks[9], (DEPTH, QK_HEAD_DIM), jnp.float32),
        'lambda_k1': LAMBDA_STD * jax.random.normal(ks[10], (DEPTH, QK_HEAD_DIM), jnp.float32),
        'lambda_q2': LAMBDA_STD * jax.random.normal(ks[11], (DEPTH, QK_HEAD_DIM), jnp.float32),
        'lambda_k2': LAMBDA_STD * jax.random.normal(ks[12], (DEPTH, QK_HEAD_DIM), jnp.float32),
        'subln': gain(ks[13], V_HEAD_DIM),
        'p_f': w(ks[14], (DEPTH, D_FOURIER, D_MODEL), D_FOURIER),
        'p_a': w(ks[15], (DEPTH, D_V, D_MODEL), D_V),
        'w_o': w(ks[16], (DEPTH, D_MODEL, D_MODEL), D_MODEL),
        'norm_ffb': gain(ks[17], D_MODEL),
        'ffb_gate': w(ks[18], (DEPTH, D_MODEL, D_FF), D_MODEL),
        'ffb_up': w(ks[19], (DEPTH, D_MODEL, D_FF), D_MODEL),
        'ffb_down': w(ks[20], (DEPTH, D_FF, D_MODEL), D_FF),
        'norm_out': gain(ks[21], D_MODEL),
    }


def reference(x, norm_ffa, ffa_gate, ffa_up, ffa_down, norm_mix, w_in, q_norm, k_norm,
              lambda_q1, lambda_k1, lambda_q2, lambda_k2, subln, p_f, p_a, w_o,
              norm_ffb, ffb_gate, ffb_up, ffb_down, norm_out):
    b, s, _ = x.shape
    cos, sin = rope_tables(s)
    splits = [D_FOURIER, D_FOURIER + D_QK, D_FOURIER + 2 * D_QK,
              D_FOURIER + 2 * D_QK + D_V, D_FOURIER + 2 * D_QK + D_V + D_MODEL]
    for i in range(DEPTH):
        lam_init = 0.8 - 0.6 * math.exp(-0.3 * i)
        x = x + 0.5 * swiglu(rms_norm(x, norm_ffa[i]), ffa_gate[i], ffa_up[i], ffa_down[i])
        h = rms_norm(x, norm_mix[i])
        z = h @ w_in[i]
        u_f, q, k, v, g_f, g_a = jnp.split(z, splits, axis=-1)
        f = fourier_mix(u_f)
        q = partial_rope(rms_norm(q.reshape(b, s, N_HEADS, 2, QK_HEAD_DIM), q_norm[i]), cos, sin)
        k = partial_rope(rms_norm(k.reshape(b, s, N_HEADS, 2, QK_HEAD_DIM), k_norm[i]), cos, sin)
        v = v.reshape(b, s, N_HEADS, V_HEAD_DIM)
        lam = (jnp.exp(jnp.sum(lambda_q1[i].astype(jnp.float32) * lambda_k1[i].astype(jnp.float32)))
               - jnp.exp(jnp.sum(lambda_q2[i].astype(jnp.float32) * lambda_k2[i].astype(jnp.float32)))
               + lam_init)
        o = diff_attention(q, k, v, lam)
        o = (rms_norm(o, subln[i]) * (1.0 - lam_init)).reshape(b, s, D_V)
        m = jax.nn.sigmoid(g_f) * (f @ p_f[i]) + jax.nn.sigmoid(g_a) * (o @ p_a[i])
        x = x + m @ w_o[i]
        x = x + 0.5 * swiglu(rms_norm(x, norm_ffb[i]), ffb_gate[i], ffb_up[i], ffb_down[i])
        x = rms_norm(x, norm_out[i])
    return x
```

```cpp
#include <hip/hip_runtime.h>
#include <cstdio>
#include <cstdint>

#ifndef MK_ONE_LAUNCH
#define MK_ONE_LAUNCH 1
#endif

namespace pg8 {
#define PG8_LAS __attribute__((address_space(3)))
typedef unsigned short bf16_t;
typedef short bf16x8 __attribute__((ext_vector_type(8)));
typedef float f32x4 __attribute__((ext_vector_type(4)));
typedef float f32x2 __attribute__((ext_vector_type(2)));
typedef unsigned u32x4 __attribute__((ext_vector_type(4)));
constexpr int BM = 256, BK = 64, HALF = 128, HTB = HALF * BK * 2, STAGE_BYTES = 8 * HTB, NXCD = 8, WGM = 8;

__host__ __device__ __forceinline__ int lds_byte(int r, int c) { const int st = (r >> 4) * 2 + (c >> 5), rr = r & 15, cc = c & 31, ob = rr * 64 + cc * 2; return st * 1024 + (ob ^ (((ob >> 9) & 1) << 5)); }
__host__ __device__ __forceinline__ void stage_rc(int b, int& R, int& C) { const int st = b / 1024, sb = b % 1024, swz = sb ^ (((sb >> 9) & 1) << 5); R = (st >> 1) * 16 + swz / 64; C = (st & 1) * 32 + (swz % 64) / 2; }
__host__ __device__ __forceinline__ int perm32(int rho) { const int n = rho >> 4, i = rho & 15; return 8 * (i >> 2) + 4 * n + (i & 3); }

struct Unit { int pm, pn, pz; };
struct Prob { const char* A; const char* B; unsigned lda, ldb; size_t sAz, sBz; int K;
              unsigned hsB; int sh1, sh2; unsigned m0, m1; size_t s0, s1, s2;
    __device__ __forceinline__ const char* bbase(const Unit& u) const { return B + (size_t)u.pz * sBz + (size_t)((unsigned)u.pn & m0) * s0 + (size_t)(((unsigned)u.pn >> sh1) & m1) * s1 + (size_t)((unsigned)u.pn >> sh2) * s2; } };
__device__ __forceinline__ Prob mk_prob(const void* A, const void* B, unsigned lda, unsigned ldb, size_t sAz, size_t sBz, int K) {
    Prob p; p.A = (const char*)A; p.B = (const char*)B; p.lda = lda; p.ldb = ldb; p.sAz = sAz; p.sBz = sBz; p.K = K; p.hsB = HALF * ldb; p.sh1 = 0; p.sh2 = 31; p.m0 = 0x7fffffffu; p.m1 = 0u; p.s0 = (size_t)BM * ldb; p.s1 = 0; p.s2 = 0; return p; }

struct GridOrder {
    int nM, nN, nZ, nwg, G, c, wgm, seg;
    __device__ void init(int nM_, int nN_, int nZ_, int G_, int c_, int wgm_ = WGM, int seg_ = 1) { nM = nM_; nN = nN_; nZ = nZ_; nwg = nM * nN; G = G_; c = c_; wgm = wgm_; seg = seg_; }
    __device__ bool next(int i, Unit& u) const {
        const long L = (seg == 2) ? (long)(i >> 1) * G + c : (long)i * G + c; if (L >= (long)nwg * nZ) return false;
        u.pz = (seg == 2) ? (i & 1) : (int)(L / nwg);
        int wgid = (int)(L % nwg); { const int q = nwg / NXCD, r = nwg % NXCD, xcd = wgid % NXCD, off = wgid / NXCD; wgid = (xcd < r ? xcd * (q + 1) : r * (q + 1) + (xcd - r) * q) + off; }
        const int nig = wgm * nN, gid = wgid / nig, fm = gid * wgm, gsz = (nM - fm) < wgm ? (nM - fm) : wgm;
        u.pm = fm + ((wgid % nig) % gsz); u.pn = (wgid % nig) / gsz; return true;
    }
};

typedef __bf16 cv_bf16x2 __attribute__((ext_vector_type(2)));
typedef float cv_f32x2 __attribute__((ext_vector_type(2)));
__device__ __forceinline__ unsigned cvt_pk_bf16(float lo, float hi) { const cv_f32x2 v = {lo, hi}; return __builtin_bit_cast(unsigned, __builtin_convertvector(v, cv_bf16x2)); }
__device__ __forceinline__ float bf_lo(unsigned w) { return __uint_as_float(w << 16); }
__device__ __forceinline__ float bf_hi(unsigned w) { return __uint_as_float(w & 0xffff0000u); }
__device__ __forceinline__ float sigmoidf_(float x) { return __builtin_amdgcn_rcpf(1.0f + __builtin_amdgcn_exp2f(-1.4426950408889634f * x)); }

#define EPI_ROWS_BEGIN _Pragma("unroll") for (int ai = 0; ai < 2; ++ai) _Pragma("unroll") for (int m = 0; m < 4; ++m) { const int row = u.pm * BM + ai * HALF + wr * 64 + m * 16 + fr;
#define EPI_ROWS_END }

struct EpiBf16 {
    struct State { float rs[8]; };
    bf16_t* O; int ldc; float scale; int zrows; const unsigned long long* ss;
    __device__ __forceinline__ void init(f32x4 (&acc)[2][2][4][2], State& st, const Unit& u, int wr, int, int fr, int) const {
        if (ss) {
#pragma unroll
            for (int ai = 0; ai < 2; ++ai)
#pragma unroll
                for (int m = 0; m < 4; ++m) st.rs[ai * 4 + m] = __builtin_amdgcn_rsqf((float)ss[u.pm * BM + ai * HALF + wr * 64 + m * 16 + fr] * (1.0f / (1048576.0f * 2048.0f)) + 1e-6f); }

#pragma unroll
        for (int a = 0; a < 2; ++a)
#pragma unroll
            for (int b = 0; b < 2; ++b)
#pragma unroll
                for (int m = 0; m < 4; ++m)
#pragma unroll
                    for (int n = 0; n < 2; ++n) acc[a][b][m][n] = (f32x4){0.f, 0.f, 0.f, 0.f}; }
    __device__ __forceinline__ void operator()(const f32x4 (&acc)[2][2][4][2], const State& st, const Unit& u, int wr, int wc, int fr, int fq) const {
        const int col0 = u.pn * BM + wc * 32 + 8 * fq;
        EPI_ROWS_BEGIN
            bf16_t* rowp = O + (size_t)(u.pz * zrows + row) * ldc + col0;
            const float rs = ss ? scale * st.rs[ai * 4 + m] : scale;
#pragma unroll
            for (int bj = 0; bj < 2; ++bj) { const f32x4 v0 = acc[ai][bj][m][0] * rs, v1 = acc[ai][bj][m][1] * rs;
                u32x4 w; w.x = cvt_pk_bf16(v0[0], v0[1]); w.y = cvt_pk_bf16(v0[2], v0[3]); w.z = cvt_pk_bf16(v1[0], v1[1]); w.w = cvt_pk_bf16(v1[2], v1[3]);
                *(u32x4*)(rowp + bj * HALF) = w; }
        EPI_ROWS_END
    }
};
struct EpiSwiglu {
    struct State { float rs[8]; };
    bf16_t* O; int ldc; const unsigned long long* ss;
    __device__ __forceinline__ void init(f32x4 (&acc)[2][2][4][2], State& st, const Unit& u, int wr, int, int fr, int) const {
        {
#pragma unroll
            for (int ai = 0; ai < 2; ++ai)
#pragma unroll
                for (int m = 0; m < 4; ++m) st.rs[ai * 4 + m] = __builtin_amdgcn_rsqf((float)ss[u.pm * BM + ai * HALF + wr * 64 + m * 16 + fr] * (1.0f / (1048576.0f * 2048.0f)) + 1e-6f); }

#pragma unroll
        for (int a = 0; a < 2; ++a)
#pragma unroll
            for (int b = 0; b < 2; ++b)
#pragma unroll
                for (int m = 0; m < 4; ++m)
#pragma unroll
                    for (int n = 0; n < 2; ++n) acc[a][b][m][n] = (f32x4){0.f, 0.f, 0.f, 0.f}; }
    __device__ __forceinline__ void operator()(const f32x4 (&acc)[2][2][4][2], const State& st, const Unit& u, int wr, int wc, int fr, int fq) const {
        const int col0 = u.pn * HALF + wc * 32 + 8 * fq;
        EPI_ROWS_BEGIN
            const float rs = st.rs[ai * 4 + m];
            float h[8];
#pragma unroll
            for (int n = 0; n < 2; ++n)
#pragma unroll
                for (int e = 0; e < 4; ++e) { const float g = acc[ai][0][m][n][e] * rs, up = acc[ai][1][m][n][e] * rs; h[n * 4 + e] = g * sigmoidf_(g) * up; }
            u32x4 w; w.x = cvt_pk_bf16(h[0], h[1]); w.y = cvt_pk_bf16(h[2], h[3]); w.z = cvt_pk_bf16(h[4], h[5]); w.w = cvt_pk_bf16(h[6], h[7]);
            *(u32x4*)(O + (size_t)row * ldc + col0) = w;
        EPI_ROWS_END
    }
};
struct EpiGate {
    struct State { float rs[8]; };
    const bf16_t* G; int ldg; const bf16_t* T; bf16_t* O; int ldc; int add;
    __device__ __forceinline__ void init(f32x4 (&acc)[2][2][4][2], State&, const Unit&, int, int, int, int) const {
#pragma unroll
        for (int a = 0; a < 2; ++a)
#pragma unroll
            for (int b = 0; b < 2; ++b)
#pragma unroll
                for (int m = 0; m < 4; ++m)
#pragma unroll
                    for (int n = 0; n < 2; ++n) acc[a][b][m][n] = (f32x4){0.f, 0.f, 0.f, 0.f}; }
    __device__ __forceinline__ void operator()(const f32x4 (&acc)[2][2][4][2], const State& st, const Unit& u, int wr, int wc, int fr, int fq) const {
        const int col0 = u.pn * BM + wc * 32 + 8 * fq;
        EPI_ROWS_BEGIN
#pragma unroll
            for (int bj = 0; bj < 2; ++bj) {
                const u32x4 gw = *(const u32x4*)(G + (size_t)row * ldg + col0 + bj * HALF);
                u32x4 tw = (u32x4){0u, 0u, 0u, 0u};
                if (add) tw = *(const u32x4*)(T + (size_t)row * ldc + col0 + bj * HALF);
                float r[8];
#pragma unroll
                for (int q = 0; q < 4; ++q) {
                    const float a0 = acc[ai][bj][m][q >> 1][(q & 1) * 2], a1 = acc[ai][bj][m][q >> 1][(q & 1) * 2 + 1];
                    r[2 * q] = bf_lo(tw[q]) + sigmoidf_(bf_lo(gw[q])) * a0; r[2 * q + 1] = bf_hi(tw[q]) + sigmoidf_(bf_hi(gw[q])) * a1; }
                u32x4 w; w.x = cvt_pk_bf16(r[0], r[1]); w.y = cvt_pk_bf16(r[2], r[3]); w.z = cvt_pk_bf16(r[4], r[5]); w.w = cvt_pk_bf16(r[6], r[7]);
                *(u32x4*)(O + (size_t)row * ldc + col0 + bj * HALF) = w; }
        EPI_ROWS_END
    }
};
struct EpiGate2 {
    struct State { float rs[8]; };
    const bf16_t* Gf; const bf16_t* Ga; int ldg; bf16_t* O; int ldc;
    __device__ __forceinline__ void init(f32x4 (&acc)[2][2][4][2], State&, const Unit& u, int, int, int, int) const {
        if (u.pz != 0) return;
#pragma unroll
        for (int a = 0; a < 2; ++a)
#pragma unroll
            for (int b = 0; b < 2; ++b)
#pragma unroll
                for (int m = 0; m < 4; ++m)
#pragma unroll
                    for (int n = 0; n < 2; ++n) acc[a][b][m][n] = (f32x4){0.f, 0.f, 0.f, 0.f}; }
    __device__ __forceinline__ void operator()(f32x4 (&acc)[2][2][4][2], const State& st, const Unit& u, int wr, int wc, int fr, int fq) const {
        const int col0 = u.pn * BM + wc * 32 + 8 * fq;
        EPI_ROWS_BEGIN
#pragma unroll
            for (int bj = 0; bj < 2; ++bj) {
                const u32x4 ga = *(const u32x4*)(Ga + (size_t)row * ldg + col0 + bj * HALF);
                if (u.pz == 0) {
                    const u32x4 gf = *(const u32x4*)(Gf + (size_t)row * ldg + col0 + bj * HALF);
#pragma unroll
                    for (int q = 0; q < 4; ++q) {
                        const float e0 = __builtin_amdgcn_exp2f(-1.4426950408889634f * bf_lo(ga[q])), e1 = __builtin_amdgcn_exp2f(-1.4426950408889634f * bf_hi(ga[q]));
                        const float f0 = __builtin_amdgcn_exp2f(-1.4426950408889634f * bf_lo(gf[q])), f1 = __builtin_amdgcn_exp2f(-1.4426950408889634f * bf_hi(gf[q]));
                        acc[ai][bj][m][q >> 1][(q & 1) * 2] *= (1.0f + e0) * __builtin_amdgcn_rcpf(1.0f + f0);
                        acc[ai][bj][m][q >> 1][(q & 1) * 2 + 1] *= (1.0f + e1) * __builtin_amdgcn_rcpf(1.0f + f1); }
                } else {
                    float r[8];
#pragma unroll
                    for (int q = 0; q < 4; ++q) { r[2 * q] = sigmoidf_(bf_lo(ga[q])) * acc[ai][bj][m][q >> 1][(q & 1) * 2]; r[2 * q + 1] = sigmoidf_(bf_hi(ga[q])) * acc[ai][bj][m][q >> 1][(q & 1) * 2 + 1]; }
                    u32x4 w; w.x = cvt_pk_bf16(r[0], r[1]); w.y = cvt_pk_bf16(r[2], r[3]); w.z = cvt_pk_bf16(r[4], r[5]); w.w = cvt_pk_bf16(r[6], r[7]);
                    *(u32x4*)(O + (size_t)row * ldc + col0 + bj * HALF) = w; }
            }
        EPI_ROWS_END
    }
};
struct EpiCstep {
    struct State { float rs[8]; };
    bf16_t* X1;
    __device__ __forceinline__ void init(f32x4 (&acc)[2][2][4][2], State&, const Unit&, int, int, int, int) const {
#pragma unroll
        for (int a = 0; a < 2; ++a)
#pragma unroll
            for (int b = 0; b < 2; ++b)
#pragma unroll
                for (int m = 0; m < 4; ++m)
#pragma unroll
                    for (int n = 0; n < 2; ++n) acc[a][b][m][n] = (f32x4){0.f, 0.f, 0.f, 0.f}; }
    __device__ __forceinline__ void operator()(const f32x4 (&acc)[2][2][4][2], const State& st, const Unit& u, int wr, int wc, int fr, int fq) const {
        const int b = u.pn >> 5, s1_0 = wc * 32 + 8 * fq;
        EPI_ROWS_BEGIN
            const int gc = u.pz * 256 + (row - u.pm * BM);
#pragma unroll
            for (int bj = 0; bj < 2; ++bj) { const int s2 = 2 * (u.pn & 31) + bj;
                const f32x4 v0 = acc[ai][bj][m][0], v1 = acc[ai][bj][m][1];
                u32x4 w; w.x = cvt_pk_bf16(v0[0], v0[1]); w.y = cvt_pk_bf16(v0[2], v0[3]); w.z = cvt_pk_bf16(v1[0], v1[1]); w.w = cvt_pk_bf16(v1[2], v1[3]);
                *(u32x4*)(X1 + ((size_t)((((gc * 2 + b) * 64 + s2) * 2 + u.pm) * 128) + s1_0)) = w; }
        EPI_ROWS_END
    }
};
struct EpiS1 {
    struct State { float rs[8]; };
    bf16_t* Y2; const float* TW;
    __device__ __forceinline__ void init(f32x4 (&acc)[2][2][4][2], State&, const Unit&, int, int, int, int) const {
#pragma unroll
        for (int a = 0; a < 2; ++a)
#pragma unroll
            for (int b = 0; b < 2; ++b)
#pragma unroll
                for (int m = 0; m < 4; ++m)
#pragma unroll
                    for (int n = 0; n < 2; ++n) acc[a][b][m][n] = (f32x4){0.f, 0.f, 0.f, 0.f}; }
    __device__ __forceinline__ void operator()(const f32x4 (&acc)[2][2][4][2], const State& st, const Unit& u, int wr, int wc, int fr, int fq) const {
        const int s2_0 = (wc & 1) * 32 + 8 * fq;
#pragma unroll
        for (int m = 0; m < 4; ++m) {
            const int s1p = wr * 64 + m * 16 + fr;
            const f32x4* tp = (const f32x4*)(TW + ((size_t)s1p * 64 + s2_0) * 2);
            const f32x4 t0 = tp[0], t1 = tp[1], t2 = tp[2], t3 = tp[3];
            const float tc[8] = {t0[0], t0[2], t1[0], t1[2], t2[0], t2[2], t3[0], t3[2]}, ts[8] = {t0[1], t0[3], t1[1], t1[3], t2[1], t2[3], t3[1], t3[3]};
#pragma unroll
            for (int bj = 0; bj < 2; ++bj) {
                const int q = u.pn * 4 + bj * 2 + (wc >> 1);
                float yr[8], yi[8];
#pragma unroll
                for (int e = 0; e < 8; ++e) { const float a = acc[0][bj][m][e >> 2][e & 3], c = acc[1][bj][m][e >> 2][e & 3]; yr[e] = a * tc[e] - c * ts[e]; yi[e] = a * ts[e] + c * tc[e]; }
                u32x4 w0, w1;
                w0.x = cvt_pk_bf16(yr[0], yr[1]); w0.y = cvt_pk_bf16(yr[2], yr[3]); w0.z = cvt_pk_bf16(yr[4], yr[5]); w0.w = cvt_pk_bf16(yr[6], yr[7]);
                w1.x = cvt_pk_bf16(yi[0], yi[1]); w1.y = cvt_pk_bf16(yi[2], yi[3]); w1.z = cvt_pk_bf16(yi[4], yi[5]); w1.w = cvt_pk_bf16(yi[6], yi[7]);
                bf16_t* dst = Y2 + ((size_t)(s1p * 2048 + q) * 2) * 64 + s2_0;
                *(u32x4*)dst = w0; *(u32x4*)(dst + 64) = w1; }
        }
    }
};
struct EpiS2 {
    struct State { float rs[8]; };
    bf16_t* F; float scale;
    __device__ __forceinline__ void init(f32x4 (&acc)[2][2][4][2], State&, const Unit&, int, int, int, int) const {
#pragma unroll
        for (int a = 0; a < 2; ++a)
#pragma unroll
            for (int b = 0; b < 2; ++b)
#pragma unroll
                for (int m = 0; m < 4; ++m)
#pragma unroll
                    for (int n = 0; n < 2; ++n) acc[a][b][m][n] = (f32x4){0.f, 0.f, 0.f, 0.f}; }
    __device__ __forceinline__ void operator()(const f32x4 (&acc)[2][2][4][2], const State& st, const Unit& u, int wr, int wc, int fr, int fq) const {
        if (wr != 0) return;
        const int gt = u.pn & 3, s1p = (u.pn >> 2) & 127, b = u.pn >> 9;
        const int col0 = gt * 256 + wc * 32 + 8 * fq;
#pragma unroll
        for (int m = 0; m < 4; ++m) { const int s2p = m * 16 + fr;
            bf16_t* rowp = F + (size_t)(b * 8192 + s1p + 128 * s2p) * 1024 + col0;
#pragma unroll
            for (int bj = 0; bj < 2; ++bj) { const f32x4 v0 = acc[0][bj][m][0] * scale, v1 = acc[0][bj][m][1] * scale;
                u32x4 w; w.x = cvt_pk_bf16(v0[0], v0[1]); w.y = cvt_pk_bf16(v0[2], v0[3]); w.z = cvt_pk_bf16(v1[0], v1[1]); w.w = cvt_pk_bf16(v1[2], v1[3]);
                *(u32x4*)(rowp + bj * HALF) = w; } }
    }
};

template <class Epi, class Sched, bool ALIGN_EPI>
__device__ __forceinline__ void gemm_phase(PG8_LAS unsigned char* lds, const Prob g, const Sched S, const Epi E, const int tid_in) {
    const int tid = tid_in, wid = __builtin_amdgcn_readfirstlane(tid >> 6), lane = tid & 63, wr = wid >> 2, wc = wid & 3, fr = lane & 15, fq = lane >> 4;
    int K = g.K; asm volatile("" : "+s"(K)); const int nt = K / BK;
    unsigned voffA[2], voffB[2];
#pragma unroll
    for (int i = 0; i < 2; ++i) { int R, C; stage_rc(tid * 16 + i * 8192, R, C); const int Rb = (R & ~31) + perm32(R & 31);
        voffA[i] = (unsigned)R * g.lda + (unsigned)C * 2u; voffB[i] = (unsigned)Rb * g.ldb + (unsigned)C * 2u; }
    const size_t kstep = (size_t)(BK * 2);
    const size_t hstepA = (size_t)HALF * g.lda, hstepB = (size_t)g.hsB;
    const size_t tstepA = 2 * hstepA;
    const unsigned ldsw = (unsigned)wid * 1024u;
    const int aoff = lds_byte(wr * 64 + fr, fq * 8), boff = lds_byte(wc * 32 + fr, fq * 8);
#define PG8_SA(b, h) (((b) * 2 + (h)) * HTB)
#define PG8_SB(b, h) ((4 + (b) * 2 + (h)) * HTB)
#define PG8_STAGE(bufoff, gbase, voff) do { _Pragma("unroll") for (int _i = 0; _i < 2; ++_i) \
        __builtin_amdgcn_global_load_lds((const unsigned*)((const char*)(gbase) + (voff)[_i]), (PG8_LAS unsigned*)(lds + (bufoff) + ldsw + _i * 8192), 16, 0, 0); } while (0)
#define PG8_LDA(dst, b, h) do { _Pragma("unroll") for (int m = 0; m < 4; ++m) _Pragma("unroll") for (int k = 0; k < 2; ++k) dst[m][k] = *(const PG8_LAS bf16x8*)(lds + PG8_SA(b, h) + aoff + m * 2048 + k * 1024); } while (0)
#define PG8_LDB(dst, b, h) do { _Pragma("unroll") for (int n = 0; n < 2; ++n) _Pragma("unroll") for (int k = 0; k < 2; ++k) dst[n][k] = *(const PG8_LAS bf16x8*)(lds + PG8_SB(b, h) + boff + n * 2048 + k * 1024); } while (0)
#define PG8_MMA(ai, bj, At, Bt) do { __builtin_amdgcn_s_setprio(1); _Pragma("unroll") for (int m = 0; m < 4; ++m) _Pragma("unroll") for (int n = 0; n < 2; ++n) _Pragma("unroll") for (int k = 0; k < 2; ++k) \
        acc[ai][bj][m][n] = __builtin_amdgcn_mfma_f32_16x16x32_bf16(Bt[n][k], At[m][k], acc[ai][bj][m][n], 0, 0, 0); __builtin_amdgcn_s_setprio(0); } while (0)
#define PG8_WAIT_V(n) asm volatile("s_waitcnt vmcnt(" #n ")" ::: "memory")
#define PG8_WAIT_L(n) asm volatile("s_waitcnt lgkmcnt(" #n ")" ::: "memory")
#define PG8_BAR __builtin_amdgcn_s_barrier()
#define PG8_SCHED __builtin_amdgcn_sched_barrier(0)
    Unit cur, nxt; int ui = 0;
    if (!S.next(0, cur)) return;
    f32x4 acc[2][2][4][2]; typename Epi::State est;
    E.init(acc, est, cur, wr, wc, fr, fq);
    bf16x8 At[4][2], B0[2][2], B1[2][2];
    const char* cA = g.A + (size_t)cur.pz * g.sAz + (size_t)cur.pm * tstepA; const char* cB = g.bbase(cur);
    PG8_STAGE(PG8_SB(0, 0), cB, voffB); PG8_STAGE(PG8_SB(0, 1), cB + hstepB, voffB); PG8_STAGE(PG8_SA(0, 0), cA, voffA); PG8_STAGE(PG8_SA(0, 1), cA + hstepA, voffA);
    if (wr == 1) PG8_BAR;
    PG8_WAIT_V(2); PG8_BAR;
    PG8_STAGE(PG8_SB(1, 0), cB + kstep, voffB); PG8_STAGE(PG8_SA(1, 0), cA + kstep, voffA); PG8_STAGE(PG8_SB(1, 1), cB + hstepB + kstep, voffB);
    PG8_WAIT_V(6); PG8_BAR;
    for (;;) {
        const bool has_next = S.next(ui + 1, nxt);
        const char* nA = has_next ? g.A + (size_t)nxt.pz * g.sAz + (size_t)nxt.pm * tstepA : cA; const char* nB = has_next ? g.bbase(nxt) : cB;
        for (int t = 0; t < nt; t += 2) {
            const bool last = (t == nt - 2);
            const char* a1 = cA + (size_t)(t + 1) * kstep;
            const char* a2 = last ? nA : cA + (size_t)(t + 2) * kstep; const char* b2 = last ? nB : cB + (size_t)(t + 2) * kstep;
            const char* a3 = a2 + kstep; const char* b3 = b2 + kstep;
            PG8_LDB(B0, 0, 0); PG8_LDB(B1, 0, 1); PG8_SCHED; PG8_LDA(At, 0, 0); PG8_STAGE(PG8_SA(1, 1), a1 + hstepA, voffA);
            PG8_WAIT_V(8); PG8_WAIT_L(0); PG8_BAR; PG8_MMA(0, 0, At, B0); PG8_MMA(0, 1, At, B1); PG8_BAR; PG8_SCHED;
            PG8_LDA(At, 0, 1); PG8_STAGE(PG8_SB(0, 0), b2, voffB); PG8_STAGE(PG8_SB(0, 1), b2 + hstepB, voffB); PG8_STAGE(PG8_SA(0, 0), a2, voffA);
            PG8_WAIT_V(8); PG8_WAIT_L(0); PG8_BAR; PG8_MMA(1, 0, At, B0); PG8_MMA(1, 1, At, B1); PG8_BAR; PG8_SCHED;
            PG8_LDB(B0, 1, 0); PG8_LDB(B1, 1, 1); PG8_SCHED; PG8_LDA(At, 1, 0); PG8_STAGE(PG8_SA(0, 1), a2 + hstepA, voffA);
            PG8_WAIT_V(8); PG8_WAIT_L(0); PG8_BAR; PG8_MMA(0, 0, At, B0); PG8_MMA(0, 1, At, B1); PG8_BAR; PG8_SCHED;
            PG8_LDA(At, 1, 1); PG8_STAGE(PG8_SB(1, 0), b3, voffB); PG8_STAGE(PG8_SB(1, 1), b3 + hstepB, voffB); PG8_STAGE(PG8_SA(1, 0), a3, voffA);
            PG8_WAIT_V(8); PG8_WAIT_L(0); PG8_BAR; PG8_MMA(1, 0, At, B0); PG8_MMA(1, 1, At, B1); PG8_BAR; PG8_SCHED;
        }
        if constexpr (ALIGN_EPI) { if (wr == 0) PG8_BAR; }
        E(acc, est, cur, wr, wc, fr, fq);
        if (!has_next) break;
        E.init(acc, est, nxt, wr, wc, fr, fq);
        cur = nxt; cA = nA; cB = nB; ++ui;
        if constexpr (ALIGN_EPI) { if (wr == 1) PG8_BAR; }
    }
    PG8_WAIT_V(0);
    if constexpr (!ALIGN_EPI) { if (wr == 0) PG8_BAR; }
    PG8_BAR;
#undef PG8_SA
#undef PG8_SB
#undef PG8_STAGE
#undef PG8_LDA
#undef PG8_LDB
#undef PG8_MMA
#undef PG8_WAIT_V
#undef PG8_WAIT_L
#undef PG8_BAR
#undef PG8_SCHED
}
}

namespace att {
typedef unsigned short bf16_t;
using bf16x8 = __attribute__((ext_vector_type(8))) short;
using s16x4  = __attribute__((ext_vector_type(4))) short;
using f32x16 = __attribute__((ext_vector_type(16))) float;
using u32x4  = __attribute__((ext_vector_type(4))) unsigned;
constexpr int NW = 8, QBLK = 32, KVBLK = 64;
constexpr int LDQ = 128, LDK = 128, LDV = 128, LDO = 1024;
#define KSWZ(row, colB) ((row) * 256 + ((colB) ^ (((row) & 7) << 4)))
#define SBAR() __builtin_amdgcn_sched_barrier(0)
template <int X> __device__ __forceinline__ float sx(float v) { return __int_as_float(__builtin_amdgcn_ds_swizzle(__float_as_int(v), 0x1f | (X << 10))); }
__device__ __forceinline__ int crow(int r, int hi) { return (r & 3) + 8 * (r >> 2) + 4 * hi; }
__device__ __forceinline__ unsigned cvtpk(float lo, float hi) { return pg8::cvt_pk_bf16(lo, hi); }
__device__ __forceinline__ int v_st(int k, int c) { const int kk = (k & ~0xC) | ((k & 4) << 1) | ((k & 8) >> 1); return ((kk >> 3) * 4 + (c >> 5)) * 512 + ((kk & 7) * 32 + (c & 31)) * 2; }
__device__ __forceinline__ int v_rd_base(int lane) { return ((lane & 3) << 3) | (((lane >> 2) & 3) << 6) | (((lane >> 4) & 1) << 5) | (((lane >> 5) & 1) << 8); }
constexpr int v_rd_off(int d0, int ks, int half) { return d0 * 512 + ks * 4096 + half * 2048; }
template <int OFF> __device__ __forceinline__ s16x4 tr_read(int vb) {
  s16x4 r; asm volatile("ds_read_b64_tr_b16 %0, %1 offset:%2" : "=&v"(r) : "v"(vb), "i"(OFF) : "memory"); return r;
}
typedef __attribute__((address_space(3))) char* lptr;
typedef short v4i16_t __attribute__((ext_vector_type(4)));
#define LDSV(T, p) (*(__attribute__((address_space(3))) T*)(p))
constexpr int KSLOT = 16640, VSLOT = 16384, NSLOT = 4, K_OFF = 0, V_OFF = NSLOT * KSLOT, WS_OFF = V_OFF + NSLOT * VSLOT;
constexpr int CH = 2080;
__device__ __forceinline__ int k_img(int key, int chunk, int h) { return chunk * CH + key * 32 + ((h ^ ((key >> 3) & 1)) * 16); }
template <int OFF> __device__ __forceinline__ bf16x8 rd128(int a) { bf16x8 r; asm volatile("ds_read_b128 %0, %1 offset:%2" : "=&v"(r) : "v"(a), "i"(OFF) : "memory"); return r; }
#define LWAIT(N) do { asm volatile("s_waitcnt lgkmcnt(" #N ")" ::: "memory"); SBAR(); } while (0)
__device__ __forceinline__ s16x4 vtr(lptr p) { return __builtin_bit_cast(s16x4, __builtin_amdgcn_ds_read_tr16_b64_v4i16((__attribute__((address_space(3))) v4i16_t*)p)); }
#define PK4(P, BASE, OUT) do { unsigned a0 = cvtpk(P[BASE + 0], P[BASE + 1]), a1 = cvtpk(P[BASE + 2], P[BASE + 3]);   \
    unsigned b0 = cvtpk(P[BASE + 4], P[BASE + 5]), b1 = cvtpk(P[BASE + 6], P[BASE + 7]);                              \
    auto r0 = __builtin_amdgcn_permlane32_swap(a0, b0, false, false); auto r1 = __builtin_amdgcn_permlane32_swap(a1, b1, false, false); \
    u32x4 w = {r0[0], r1[0], r0[1], r1[1]}; OUT = *reinterpret_cast<bf16x8*>(&w); } while (0)
template <bool SHIFT>
__device__ __forceinline__ void attn_unit(const bf16_t* __restrict__ Qb, const bf16_t* __restrict__ Kh, const bf16_t* __restrict__ Vh, bf16_t* __restrict__ Ob,
                                          int seq, float negshift, float lam, const float* __restrict__ gsub, float oscale, float eps, lptr lds, const int wave_in) {
  int lane_s; asm volatile("v_mbcnt_lo_u32_b32 %0, -1, 0\n\tv_mbcnt_hi_u32_b32 %0, -1, %0" : "=v"(lane_s));
  const int wid = wave_in, lane = lane_s, tid = wid * 64 + lane, r32 = lane & 31, hi = lane >> 5, comp = wid >> 2, wq = wid & 3;
#define UNI(x) __builtin_bit_cast(float, __builtin_amdgcn_readfirstlane(__builtin_bit_cast(int, (x))))
  lam = UNI(lam); oscale = UNI(oscale); eps = UNI(eps); negshift = UNI(negshift);
#undef UNI
  float l = 0.f; f32x16 o[4] = {}; bf16x8 qr[4];
  const bf16_t* Qw = Qb + (long)(wq * QBLK + r32) * LDQ + comp * 64 + hi * 8;
#pragma unroll
  for (int d0 = 0; d0 < 4; ++d0) qr[d0] = *reinterpret_cast<const bf16x8*>(Qw + d0 * 16);
  const int sr = tid >> 4, sc = (tid & 15) * 8;
  const lptr kwr = lds + K_OFF + k_img(sr, sc >> 4, (sc >> 3) & 1);
  const lptr vwr = lds + V_OFF + v_st(sr, sc);
  const lptr krd = lds + K_OFF + k_img(r32, comp * 4, hi);
  const lptr vrd = lds + V_OFF + v_rd_base(lane);
  unsigned voffK = (unsigned)(sr * LDK + sc) * 2u, voffV = (unsigned)(sr * LDV + sc) * 2u; asm volatile("" : "+v"(voffK), "+v"(voffV));
  const char* kg = (const char*)Kh; const char* vg = (const char*)Vh;
  bf16x8 vs0, vs1, ks0, ks1;
#define SLOAD() do { vs0 = *reinterpret_cast<const bf16x8*>(vg + voffV); vs1 = *reinterpret_cast<const bf16x8*>(vg + (size_t)32 * LDV * 2 + voffV); \
    ks0 = *reinterpret_cast<const bf16x8*>(kg + voffK); ks1 = *reinterpret_cast<const bf16x8*>(kg + (size_t)32 * LDK * 2 + voffK); kg += (size_t)KVBLK * LDK * 2; vg += (size_t)KVBLK * LDV * 2; } while (0)
#define SWRITE(sl) do { LDSV(bf16x8, vwr + (sl) * VSLOT) = vs0; LDSV(bf16x8, vwr + (sl) * VSLOT + 8192) = vs1; LDSV(bf16x8, kwr + (sl) * KSLOT) = ks0; LDSV(bf16x8, kwr + (sl) * KSLOT + 1024) = ks1; } while (0)
#define MSTEP(SC, SN, PP, PC, KO, VS, H, DO_QK, DO_PV) do { \
    bf16x8 kf[4]; s16x4 vl[4][2], vh[4][2]; \
    if (DO_QK) { _Pragma("unroll") for (int d0 = 0; d0 < 4; ++d0) kf[d0] = LDSV(const bf16x8, krd + (KO) + d0 * CH); } \
    if (DO_PV) { _Pragma("unroll") for (int d0 = 0; d0 < 4; ++d0) _Pragma("unroll") for (int ks = 0; ks < 2; ++ks) { \
        vl[d0][ks] = vtr(vrd + (VS) * VSLOT + v_rd_off(d0, 2 * (H) + ks, 0)); vh[d0][ks] = vtr(vrd + (VS) * VSLOT + v_rd_off(d0, 2 * (H) + ks, 1)); } } \
    if (DO_QK) { const f32x16 z = {}; SN = __builtin_amdgcn_mfma_f32_32x32x16_bf16(kf[0], qr[0], z, 0, 0, 0); \
        _Pragma("unroll") for (int d0 = 1; d0 < 4; ++d0) SN = __builtin_amdgcn_mfma_f32_32x32x16_bf16(kf[d0], qr[d0], SN, 0, 0, 0); } \
    { _Pragma("unroll") for (int r = 0; r < 16; ++r) SC[r] = __builtin_amdgcn_exp2f(SHIFT ? SC[r] + negshift : SC[r]); \
      float ps = 0.f; _Pragma("unroll") for (int r = 0; r < 16; ++r) ps += SC[r]; l += ps; \
      PK4(SC, 0, PC[0]); PK4(SC, 8, PC[1]); } \
    if (DO_PV) { _Pragma("unroll") for (int d0 = 0; d0 < 4; ++d0) _Pragma("unroll") for (int ks = 0; ks < 2; ++ks) { \
        const bf16x8 vf = (bf16x8){vl[d0][ks][0], vl[d0][ks][1], vl[d0][ks][2], vl[d0][ks][3], vh[d0][ks][0], vh[d0][ks][1], vh[d0][ks][2], vh[d0][ks][3]}; \
        o[d0] = __builtin_amdgcn_mfma_f32_32x32x16_bf16(PP[ks], vf, o[d0], 0, 0, 0); } } \
      \
    __builtin_amdgcn_sched_group_barrier(0x100, 20, 0); if (SHIFT) __builtin_amdgcn_sched_group_barrier(0x002, 16, 0); \
    _Pragma("unroll") for (int i_ = 0; i_ < 8; ++i_) { __builtin_amdgcn_sched_group_barrier(0x008, 1, 0); __builtin_amdgcn_sched_group_barrier(0x400, 2, 0); __builtin_amdgcn_sched_group_barrier(0x002, 2, 0); } \
    _Pragma("unroll") for (int i_ = 0; i_ < 4; ++i_) { __builtin_amdgcn_sched_group_barrier(0x008, 1, 0); __builtin_amdgcn_sched_group_barrier(0x002, 3, 0); } \
    SBAR(); } while (0)
#define STEP(TM, DO_PREV, DO_NEXT, DO_WR, DO_LD) do { \
    __syncthreads(); \
    MSTEP(sA, sB, pY, pX, (TM) * KSLOT + 1024, ((TM) + 3) & 3, 1, true, DO_PREV); \
    if (DO_WR) SWRITE(((TM) + 2) & 3); \
    if (DO_LD) SLOAD(); \
    MSTEP(sB, sA, pX, pY, (((TM) + 1) & 3) * KSLOT, TM, 0, DO_NEXT, true); } while (0)
  const int NT = seq / KVBLK;
  f32x16 sA, sB; bf16x8 pX[2], pY[2];
  SLOAD(); SWRITE(0); SLOAD(); SWRITE(1); SLOAD();
  __syncthreads();
  { const f32x16 z = {}; sA = __builtin_amdgcn_mfma_f32_32x32x16_bf16(LDSV(const bf16x8, krd), qr[0], z, 0, 0, 0);
#pragma unroll
    for (int d0 = 1; d0 < 4; ++d0) sA = __builtin_amdgcn_mfma_f32_32x32x16_bf16(LDSV(const bf16x8, krd + d0 * CH), qr[d0], sA, 0, 0, 0); }
  STEP(0, false, true, true, true);
  STEP(1, true, true, true, true); STEP(2, true, true, true, true); STEP(3, true, true, true, true);
  for (int t = 4; t + 4 < NT; t += 4) {
    STEP(0, true, true, true, true); STEP(1, true, true, true, true); STEP(2, true, true, true, true); STEP(3, true, true, true, true);
  }
  STEP(0, true, true, true, true);
  STEP(1, true, true, true, false);
  STEP(2, true, true, false, false);
  STEP(3, true, false, false, false);
  { s16x4 vl[4][2], vh[4][2];
#pragma unroll
    for (int d0 = 0; d0 < 4; ++d0)
#pragma unroll
      for (int ks = 0; ks < 2; ++ks) { vl[d0][ks] = vtr(vrd + 3 * VSLOT + v_rd_off(d0, 2 + ks, 0)); vh[d0][ks] = vtr(vrd + 3 * VSLOT + v_rd_off(d0, 2 + ks, 1)); }
#pragma unroll
    for (int d0 = 0; d0 < 4; ++d0)
#pragma unroll
      for (int ks = 0; ks < 2; ++ks) { const bf16x8 vf = (bf16x8){vl[d0][ks][0], vl[d0][ks][1], vl[d0][ks][2], vl[d0][ks][3], vh[d0][ks][0], vh[d0][ks][1], vh[d0][ks][2], vh[d0][ks][3]};
        o[d0] = __builtin_amdgcn_mfma_f32_32x32x16_bf16(pY[ks], vf, o[d0], 0, 0, 0); } }
#undef MSTEP
#undef SLOAD
#undef SWRITE
#undef STEP
  { auto rr = __builtin_amdgcn_permlane32_swap(__float_as_uint(l), __float_as_uint(l), false, false); l = __uint_as_float(rr[0]) + __uint_as_float(rr[1]); }
  int lane_e; asm volatile("v_mbcnt_lo_u32_b32 %0, -1, 0\n\tv_mbcnt_hi_u32_b32 %0, -1, %0" : "=v"(lane_e));
  const int r32e = lane_e & 31, hie = lane_e >> 5;
  __attribute__((address_space(3))) float* wse = (__attribute__((address_space(3))) float*)(lds + WS_OFF) + wid * 64;
  if (hie == 0) wse[r32e] = l;
  __syncthreads();
  lptr xb = lds + wq * (32 * 128 * 4) + (4 * hie * 128 + r32e) * 4;
  lptr wl = (lptr)wse + 4 * hie * 4;
  asm volatile("" : "+v"(xb), "+v"(wl));
#define CR(r) (((r) & 3) + 8 * ((r) >> 2))
  if (comp == 1) {
#pragma unroll
    for (int r = 0; r < 16; ++r) { const float c1 = lam * __builtin_amdgcn_rcpf(LDSV(float, wl + CR(r) * 4));
#pragma unroll
      for (int d0 = 0; d0 < 4; ++d0) LDSV(float, xb + CR(r) * 512 + d0 * 128) = o[d0][r] * c1; }
  }
  __syncthreads();
  if (comp == 0) {
    float gs[4];
#pragma unroll
    for (int d0 = 0; d0 < 4; ++d0) gs[d0] = gsub[d0 * 32 + r32e] * oscale;
    char* Ow = (char*)(Ob + (long)(wq * QBLK) * LDO);
    unsigned lofs = (unsigned)((4 * hie * LDO + r32e) * 2); asm volatile("" : "+v"(lofs));
#pragma unroll
    for (int r = 0; r < 16; ++r) {
      const float c0 = __builtin_amdgcn_rcpf(LDSV(float, wl + CR(r) * 4));
      float v[4]; float ss = 0.f;
#pragma unroll
      for (int d0 = 0; d0 < 4; ++d0) { v[d0] = o[d0][r] * c0 - LDSV(float, xb + CR(r) * 512 + d0 * 128); ss += v[d0] * v[d0]; }
      ss += sx<1>(ss); ss += sx<2>(ss); ss += sx<4>(ss); ss += sx<8>(ss); ss += sx<16>(ss);
      const float rs = __builtin_amdgcn_rsqf(ss * (1.0f / 128.0f) + eps);
#pragma unroll
      for (int d0 = 0; d0 < 4; ++d0) { const unsigned w = cvtpk(v[d0] * rs * gs[d0], 0.f); *(__attribute__((address_space(1))) bf16_t*)(Ow + (size_t)(CR(r) * LDO * 2 + d0 * 64) + lofs) = (bf16_t)(w & 0xffffu); }
    }
  }
#undef CR
  __syncthreads();
}
#undef LDSV
#undef KSWZ
#undef SBAR
}

constexpr int NWAVES = 8;
constexpr int BATCH = 2, SEQ = 8192, DM = 2048, DEPTH = 4, M = BATCH * SEQ;
constexpr int DFF = 5632, DIN = 8192, DFOUR = 1024, NHEAD = 8, QKD = 64, VD = 128;
constexpr float EPS = 1e-6f;
constexpr int ZC_UF = 0, ZC_Q = 1024, ZC_K = 2048, ZC_V = 3072, ZC_GF = 4096, ZC_GA = 6144;

constexpr size_t MiB = 1u << 20;
constexpr size_t WS_CTL = 0, CTL_ZERO_BYTES = 2 * MiB;
constexpr size_t WS_ROPE = 2 * MiB;
constexpr size_t WS_DFTC = 2 * MiB + 512 * 1024;
constexpr size_t WS_WBIG = WS_DFTC + 256 * 1024;
constexpr size_t WS_W2P  = WS_WBIG + 128 * 1024;
constexpr size_t WS_TW   = WS_W2P + 64 * 1024;
constexpr size_t WS_W = 3 * MiB, W_LAYER = 180 * MiB;
constexpr size_t WL_GUA = 0, WL_DA = 44 * MiB, WL_IN = 66 * MiB, WL_PF = 98 * MiB, WL_PA = 102 * MiB, WL_WO = 106 * MiB, WL_GUB = 114 * MiB, WL_DB = 158 * MiB;
constexpr size_t WS_H = WS_W + 4 * W_LAYER;
constexpr size_t WS_Z = WS_H + 64 * MiB;
constexpr size_t WS_QN = WS_Z + 256 * MiB, WS_KN = WS_QN + 32 * MiB;
constexpr size_t WS_ZT = WS_KN + 32 * MiB;
constexpr size_t WS_Y2 = WS_ZT + 64 * MiB;
constexpr size_t WS_F = WS_Y2 + 64 * MiB, WS_O = WS_F + 32 * MiB, WS_VN = WS_O + 32 * MiB, WS_END = WS_VN + 32 * MiB;
static_assert(WS_TW + 64 * 1024 <= WS_W, "tables fit below the weights");
constexpr int CW_BAR = 4096;
constexpr size_t WS_SSACC = 64 * 1024;
constexpr size_t WS_SSFFA = WS_SSACC + 8 * 131072;
static_assert(WS_SSFFA + 4 * 131072 <= CTL_ZERO_BYTES, "statistics inside the control region");
constexpr float SS_FIX = 1048576.0f, SS_INV = 1.0f / (1048576.0f * 2048.0f);

constexpr int RING_OFF = 0, RING_BYTES = 131072;
constexpr int LDSCTL_OFF = RING_BYTES + 4096, MISC_OFF = LDSCTL_OFF + 320;
constexpr int LDS_BYTES = 147456;

#define GAS __attribute__((address_space(1)))
#define LAS __attribute__((address_space(3)))
typedef unsigned short bf16;
typedef unsigned v4u __attribute__((ext_vector_type(4)));
typedef float f32x4 __attribute__((ext_vector_type(4)));
typedef GAS unsigned gu32;
#define RLX_AGENT __ATOMIC_RELAXED, __HIP_MEMORY_SCOPE_AGENT
#define LDS_WAIT() asm volatile("s_waitcnt lgkmcnt(0)" ::: "memory")
__device__ __forceinline__ unsigned f2bf(float f) { unsigned u = __builtin_bit_cast(unsigned, f); return (u + 0x7fffu + ((u >> 16) & 1u)) >> 16; }
__device__ __forceinline__ unsigned pk2(float lo, float hi) { return f2bf(lo) | (f2bf(hi) << 16); }

#define XB_TMO      128
#define XB_XCNT(j)  (256  + 64 * (j))
#define XB_XSUB(j)  (1280 + 64 * (j))
#define XB_XGEN(j)  (2304 + 64 * (j))
#define XB_TOP      3328
#define XB_TOPGEN   3392
#define XCD_BAR_WORDS 3456
#define XB_SPIN_CAP (1u << 18)
__device__ __forceinline__ unsigned xb_ld(unsigned* p)              { return __hip_atomic_load(p, __ATOMIC_RELAXED, __HIP_MEMORY_SCOPE_AGENT); }
__device__ __forceinline__ unsigned xb_add(unsigned* p, unsigned v) { return __hip_atomic_fetch_add(p, v, __ATOMIC_RELAXED, __HIP_MEMORY_SCOPE_AGENT); }
__device__ __forceinline__ unsigned xb_xcc_id() { return (unsigned)__builtin_amdgcn_s_getreg((3 << 11) | 20) & 0xFu; }
#define XB_SPIN(cond, bar) do { unsigned _sp = 0; while (cond) { __builtin_amdgcn_s_sleep(1); \
    if ((++_sp & 255u) == 0u) { if (xb_ld(&(bar)[XB_TMO])) break; if (_sp > XB_SPIN_CAP) { atomicAdd(&(bar)[XB_TMO], 1u); break; } } } } while (0)
struct XcdBarrier { unsigned* bar; unsigned x; volatile LAS unsigned* st; };
__device__ __forceinline__ XcdBarrier xcd_barrier_post(unsigned* bar, volatile LAS unsigned* st) {
    XcdBarrier b; b.bar = bar; b.x = xb_xcc_id(); b.st = st;
    if (threadIdx.x == 0) (void)xb_add(&bar[XB_XCNT(b.x)], 1u);
    return b;
}
__device__ __forceinline__ void xcd_barrier_complete(unsigned* bar, unsigned x, unsigned& nloc, unsigned& nx) {
    const unsigned G = gridDim.x * gridDim.y * gridDim.z;
    unsigned sum, cnt, mine, sp = 0u;
    for (;;) {
        sum = 0u; cnt = 0u; mine = 0u;
#pragma unroll
        for (unsigned j = 0; j < 16; ++j) { const unsigned c = xb_ld(&bar[XB_XCNT(j)]); sum += c; cnt += (c > 0u) ? 1u : 0u; mine = (j == x) ? c : mine; }
        if (sum == G) break;
        __builtin_amdgcn_s_sleep(1);
        if ((++sp & 255u) == 0u) { if (xb_ld(&bar[XB_TMO])) break; if (sp > XB_SPIN_CAP) { atomicAdd(&bar[XB_TMO], 1u); break; } }
    }
    nloc = mine > 0u ? mine : 1u; nx = cnt > 0u ? cnt : 1u;
}
__device__ __forceinline__ void xcd_barrier(const XcdBarrier& b) {
    asm volatile("s_waitcnt vmcnt(0)" ::: "memory");
    __syncthreads();
    if (threadIdx.x == 0) {
        unsigned* bar = b.bar;
        __builtin_amdgcn_s_waitcnt(0);
        unsigned nloc = b.st[0], nx = b.st[1];
        if (nloc == 0u) { xcd_barrier_complete(bar, b.x, nloc, nx); b.st[0] = nloc; b.st[1] = nx; }
        const unsigned old = xb_add(&bar[XB_XSUB(b.x)], 1u);
        const unsigned gen = old / nloc;
        if (old + 1u == (gen + 1u) * nloc) {
            __builtin_amdgcn_fence(__ATOMIC_RELEASE, "agent");
            asm volatile("s_waitcnt vmcnt(0)" ::: "memory");
            const unsigned og = xb_add(&bar[XB_TOP], 1u);
            const unsigned tg = og / nx;
            if (og + 1u == (tg + 1u) * nx) xb_add(&bar[XB_TOPGEN], 1u);
            else XB_SPIN(xb_ld(&bar[XB_TOPGEN]) == tg, bar);
            __builtin_amdgcn_fence(__ATOMIC_ACQUIRE, "agent");
            xb_add(&bar[XB_XGEN(b.x)], 1u);
            asm volatile("s_waitcnt vmcnt(0)" ::: "memory");
        } else {
            XB_SPIN(xb_ld(&bar[XB_XGEN(b.x)]) == gen, bar);
            __builtin_amdgcn_fence(__ATOMIC_ACQUIRE, "agent");
            asm volatile("s_waitcnt vmcnt(0)" ::: "memory");
        }
    }
    __syncthreads();
}

template <int X> __device__ __forceinline__ float swz_xor(float v) { return __int_as_float(__builtin_amdgcn_ds_swizzle(__float_as_int(v), 0x1f | (X << 10))); }
__device__ __forceinline__ float half_swap(float v) { auto rr = __builtin_amdgcn_permlane32_swap(__float_as_uint(v), __float_as_uint(v), false, false); return __uint_as_float(rr[0]) + __uint_as_float(rr[1]) - v; }
__device__ __forceinline__ float wave_sum(float v) {
    v += swz_xor<1>(v); v += swz_xor<2>(v); v += swz_xor<4>(v); v += swz_xor<8>(v); v += swz_xor<16>(v);
    { auto rr = __builtin_amdgcn_permlane32_swap(__float_as_uint(v), __float_as_uint(v), false, false); v = __uint_as_float(rr[0]) + __uint_as_float(rr[1]); }
    return v;
}
__device__ __forceinline__ float wave_max(float v) {
    v = fmaxf(v, swz_xor<1>(v)); v = fmaxf(v, swz_xor<2>(v)); v = fmaxf(v, swz_xor<4>(v)); v = fmaxf(v, swz_xor<8>(v)); v = fmaxf(v, swz_xor<16>(v));
    { auto rr = __builtin_amdgcn_permlane32_swap(__float_as_uint(v), __float_as_uint(v), false, false); v = fmaxf(__uint_as_float(rr[0]), __uint_as_float(rr[1])); }
    return v;
}
__device__ __forceinline__ void transpose_item(const float* W, int K, int N, bf16* WT, int map, LAS float* scr, int item, int lane, const float* gk = nullptr) {
    const int nblk = N / 32, kb = item / nblk, nb = item % nblk, k0 = 64 * kb, n0 = 32 * nb;
    const int r0 = (map == 0 || map == 3) ? n0 : (256 * (n0 >> 7) + (n0 & 127) + (map == 2 ? 128 : 0));
    const bool qkperm = (map == 3) && n0 >= 1024 && n0 < 3072;
#pragma unroll 8
    for (int i = 0; i < 32; ++i) { const int kk = 2 * i + (lane >> 5); scr[kk * 33 + (lane & 31)] = W[(size_t)(k0 + kk) * N + n0 + (lane & 31)]; }
    LDS_WAIT(); asm volatile("" ::: "memory");
    const int c = lane & 7;
    f32x4 ga = (f32x4){1.f, 1.f, 1.f, 1.f}, gb = ga;
    if (gk) { ga = *(const GAS f32x4*)(gk + k0 + 8 * c); gb = *(const GAS f32x4*)(gk + k0 + 8 * c + 4); }
#pragma unroll
    for (int j = 0; j < 4; ++j) { const int n = (lane >> 3) + 8 * j; const LAS float* s = scr + (8 * c) * 33 + n;
        v4u o; o.x = pk2(s[0 * 33] * ga.x, s[1 * 33] * ga.y); o.y = pk2(s[2 * 33] * ga.z, s[3 * 33] * ga.w); o.z = pk2(s[4 * 33] * gb.x, s[5 * 33] * gb.y); o.w = pk2(s[6 * 33] * gb.z, s[7 * 33] * gb.w);
        int rr = r0 + n;
        if (qkperm) { const int cc = n0 + n - 1024, hc = cc >> 6, d = cc & 63; rr = 1024 + 256 * (hc >> 2) + 128 * ((d >> 3) & 1) + 32 * (hc & 3) + 8 * (d >> 4) + 4 * ((d >> 2) & 1) + (d & 3); }
        *(GAS v4u*)(WT + (size_t)rr * K + k0 + 8 * c) = o; }
    LDS_WAIT(); asm volatile("" ::: "memory");
}
__device__ __forceinline__ void rms_row_to_bf16(const float* xrow, const f32x4 (&g)[8], bf16* orow, int lane) {
    const GAS f32x4* xr = (const GAS f32x4*)xrow + lane;
    f32x4 v[8]; float s = 0.f;
#pragma unroll
    for (int j = 0; j < 8; ++j) { v[j] = xr[64 * j]; s += (v[j].x * v[j].x + v[j].y * v[j].y) + (v[j].z * v[j].z + v[j].w * v[j].w); }
    const float rstd = 1.f / sqrtf(wave_sum(s) * (1.f / DM) + EPS);
    GAS unsigned long long* o8 = (GAS unsigned long long*)orow + lane;
#pragma unroll
    for (int j = 0; j < 8; ++j) { const f32x4 y = v[j] * rstd * g[j]; o8[64 * j] = (unsigned long long)pk2(y.x, y.y) | ((unsigned long long)pk2(y.z, y.w) << 32); }
}

__device__ __forceinline__ float row_to_bf16_ss(const float* xrow, bf16* orow, int lane) {
    const GAS f32x4* xr = (const GAS f32x4*)xrow + lane;
    GAS unsigned long long* o8 = (GAS unsigned long long*)orow + lane;
    float s = 0.f;
#pragma unroll
    for (int j = 0; j < 8; ++j) { const f32x4 v = xr[64 * j]; s += (v.x * v.x + v.y * v.y) + (v.z * v.z + v.w * v.w); o8[64 * j] = (unsigned long long)pk2(v.x, v.y) | ((unsigned long long)pk2(v.z, v.w) << 32); }
    return wave_sum(s);
}

struct Args { const float* in[22]; float* out; unsigned char* ws; int ph_lo, ph_hi; };


struct EpiWin {
    struct State { float rs[8]; };
    const Args* ka; const unsigned long long* ss; const float* gq; const float* gk;
    __device__ __forceinline__ void init(pg8::f32x4 (&acc)[2][2][4][2], State& st, const pg8::Unit& u, int wr, int, int fr, int) const {
        using pg8::f32x4; using pg8::BM; using pg8::HALF;
#pragma unroll
        for (int ai = 0; ai < 2; ++ai)
#pragma unroll
            for (int m = 0; m < 4; ++m) st.rs[ai * 4 + m] = __builtin_amdgcn_rsqf((float)ss[u.pm * BM + ai * HALF + wr * 64 + m * 16 + fr] * (1.0f / (1048576.0f * 2048.0f)) + 1e-6f);
#pragma unroll
        for (int a = 0; a < 2; ++a)
#pragma unroll
            for (int b = 0; b < 2; ++b)
#pragma unroll
                for (int m = 0; m < 4; ++m)
#pragma unroll
                    for (int n = 0; n < 2; ++n) acc[a][b][m][n] = (f32x4){0.f, 0.f, 0.f, 0.f};
    }
    __device__ __forceinline__ void operator()(const pg8::f32x4 (&acc)[2][2][4][2], const State& st, const pg8::Unit& u, int wr, int wc, int fr, int fq) const {
        using pg8::f32x4; using pg8::u32x4; using pg8::BM; using pg8::HALF; using pg8::cvt_pk_bf16;
        GAS unsigned char* wsb = (GAS unsigned char*)ka->ws;
        if (u.pn < 4 || u.pn >= 16) {
            GAS bf16* Z = (GAS bf16*)(wsb + WS_Z); const int col0 = u.pn * BM + wc * 32 + 8 * fq;
#pragma unroll
            for (int ai = 0; ai < 2; ++ai)
#pragma unroll
                for (int m = 0; m < 4; ++m) { const int row = u.pm * BM + ai * HALF + wr * 64 + m * 16 + fr; const float rs = st.rs[ai * 4 + m];
#pragma unroll
                    for (int bj = 0; bj < 2; ++bj) { const f32x4 v0 = acc[ai][bj][m][0] * rs, v1 = acc[ai][bj][m][1] * rs;
                        u32x4 w; w.x = cvt_pk_bf16(v0[0], v0[1]); w.y = cvt_pk_bf16(v0[2], v0[3]); w.z = cvt_pk_bf16(v1[0], v1[1]); w.w = cvt_pk_bf16(v1[2], v1[3]);
                        *(GAS u32x4*)(Z + (size_t)row * DIN + col0 + bj * HALF) = w; } }
        } else if (u.pn >= 12) {
            GAS bf16* V = (GAS bf16*)(wsb + WS_VN);
#pragma unroll
            for (int ai = 0; ai < 2; ++ai)
#pragma unroll
                for (int m = 0; m < 4; ++m) { const int row = u.pm * BM + ai * HALF + wr * 64 + m * 16 + fr; const float rs = st.rs[ai * 4 + m]; const int b = row >> 13, sq = row & 8191;
#pragma unroll
                    for (int bj = 0; bj < 2; ++bj) { const f32x4 v0 = acc[ai][bj][m][0] * rs, v1 = acc[ai][bj][m][1] * rs;
                        u32x4 w; w.x = cvt_pk_bf16(v0[0], v0[1]); w.y = cvt_pk_bf16(v0[2], v0[3]); w.z = cvt_pk_bf16(v1[0], v1[1]); w.w = cvt_pk_bf16(v1[2], v1[3]);
                        *(GAS u32x4*)(V + ((size_t)((b * NHEAD + 2 * (u.pn - 12) + bj) * SEQ + sq) * 128) + wc * 32 + 8 * fq) = w; } }
        } else {
            const int hca = 4 * (u.pn - 4) + wc, isk = hca >> 4, hc = hca & 15, hh = hc >> 1, cmp = hc & 1;
            GAS bf16* D = (GAS bf16*)(wsb + (isk ? WS_KN : WS_QN)); const GAS float* gg = (const GAS float*)(isk ? gk : gq) + 16 * fq;
            const GAS float* rope = (const GAS float*)(wsb + WS_ROPE);
            f32x4 g4[2][2];
#pragma unroll
            for (int bj = 0; bj < 2; ++bj)
#pragma unroll
                for (int n = 0; n < 2; ++n) g4[bj][n] = *(const GAS f32x4*)(gg + 8 * bj + 4 * n);
            const float qs = isk ? 1.0f : 0.125f * 1.4426950408889634f;
#pragma unroll
            for (int ai = 0; ai < 2; ++ai)
#pragma unroll
                for (int m = 0; m < 4; ++m) { const int row = u.pm * BM + ai * HALF + wr * 64 + m * 16 + fr; const float rs = st.rs[ai * 4 + m]; const int b = row >> 13, sq = row & 8191;
                    f32x4 x[2][2]; float q2 = 0.f;
#pragma unroll
                    for (int bj = 0; bj < 2; ++bj)
#pragma unroll
                        for (int n = 0; n < 2; ++n) { x[bj][n] = acc[ai][bj][m][n] * rs; q2 += (x[bj][n][0] * x[bj][n][0] + x[bj][n][1] * x[bj][n][1]) + (x[bj][n][2] * x[bj][n][2] + x[bj][n][3] * x[bj][n][3]); }
                    q2 += __int_as_float(__builtin_amdgcn_ds_swizzle(__float_as_int(q2), 0x1f | (16 << 10)));
                    { auto rr = __builtin_amdgcn_permlane32_swap(__float_as_uint(q2), __float_as_uint(q2), false, false); q2 = __uint_as_float(rr[0]) + __uint_as_float(rr[1]); }
                    const float rh = __builtin_amdgcn_rsqf(q2 * (1.0f / 64.0f) + 1e-6f);
#pragma unroll
                    for (int bj = 0; bj < 2; ++bj)
#pragma unroll
                        for (int n = 0; n < 2; ++n) x[bj][n] = x[bj][n] * rh * g4[bj][n];
                    if (fq == 0) {
                        const f32x4 c0 = *(const GAS f32x4*)(rope + sq * 16), c1 = *(const GAS f32x4*)(rope + sq * 16 + 4), s0 = *(const GAS f32x4*)(rope + sq * 16 + 8), s1 = *(const GAS f32x4*)(rope + sq * 16 + 12);
                        const f32x4 a0 = x[0][0], a1 = x[0][1], b0 = x[1][0], b1 = x[1][1];
                        x[0][0] = a0 * c0 - b0 * s0; x[0][1] = a1 * c1 - b1 * s1; x[1][0] = b0 * c0 + a0 * s0; x[1][1] = b1 * c1 + a1 * s1; }
                    GAS bf16* dp = D + ((size_t)((b * NHEAD + hh) * SEQ + sq) * 128) + cmp * 64 + 16 * fq;
#pragma unroll
                    for (int bj = 0; bj < 2; ++bj) { const f32x4 v0 = x[bj][0] * qs, v1 = x[bj][1] * qs;
                        u32x4 w; w.x = cvt_pk_bf16(v0[0], v0[1]); w.y = cvt_pk_bf16(v0[2], v0[3]); w.z = cvt_pk_bf16(v1[0], v1[1]); w.w = cvt_pk_bf16(v1[2], v1[3]);
                        *(GAS u32x4*)(dp + 8 * bj) = w; } }
        }
    }
};
template <int ALPHA2> struct EpiResid {
    struct State { };
    const Args* ka; int base_in; unsigned ss_off;
    __device__ __forceinline__ void init(pg8::f32x4 (&acc)[2][2][4][2], State&, const pg8::Unit& u, int wr, int wc, int fr, int fq) const {
        using pg8::f32x4; using pg8::BM; using pg8::HALF;
        const int col0 = u.pn * BM + wc * 32 + 8 * fq;
        if (base_in) {
            const GAS float* base = (const GAS float*)ka->in[0];
#pragma unroll
            for (int ai = 0; ai < 2; ++ai)
#pragma unroll
                for (int m = 0; m < 4; ++m) { const size_t off = (size_t)(u.pm * BM + ai * HALF + wr * 64 + m * 16 + fr) * DM + col0;
#pragma unroll
                    for (int bj = 0; bj < 2; ++bj)
#pragma unroll
                        for (int n = 0; n < 2; ++n) acc[ai][bj][m][n] = *(const GAS f32x4*)(base + off + bj * HALF + 4 * n) * (2.0f / ALPHA2); }
        } else {
            const GAS bf16* xb = (const GAS bf16*)((GAS unsigned char*)ka->ws + WS_H);
#pragma unroll
            for (int ai = 0; ai < 2; ++ai)
#pragma unroll
                for (int m = 0; m < 4; ++m) { const size_t off = (size_t)(u.pm * BM + ai * HALF + wr * 64 + m * 16 + fr) * DM + col0;
#pragma unroll
                    for (int bj = 0; bj < 2; ++bj) { const pg8::u32x4 w = *(const GAS pg8::u32x4*)(xb + off + bj * HALF);
                        acc[ai][bj][m][0] = (f32x4){pg8::bf_lo(w.x), pg8::bf_hi(w.x), pg8::bf_lo(w.y), pg8::bf_hi(w.y)} * (2.0f / ALPHA2);
                        acc[ai][bj][m][1] = (f32x4){pg8::bf_lo(w.z), pg8::bf_hi(w.z), pg8::bf_lo(w.w), pg8::bf_hi(w.w)} * (2.0f / ALPHA2); } }
        }
    }
    __device__ __forceinline__ void operator()(const pg8::f32x4 (&acc)[2][2][4][2], const State& st, const pg8::Unit& u, int wr, int wc, int fr, int fq) const {
        using pg8::f32x4; using pg8::u32x4; using pg8::BM; using pg8::HALF;
        GAS unsigned char* wsb = (GAS unsigned char*)ka->ws; GAS bf16* xb = (GAS bf16*)(wsb + WS_H); GAS unsigned long long* ssacc = (GAS unsigned long long*)(wsb + ss_off);
        const float alpha = 0.5f * ALPHA2;
        const int col0 = u.pn * BM + wc * 32 + 8 * fq;
#pragma unroll
        for (int ai = 0; ai < 2; ++ai)
#pragma unroll
            for (int m = 0; m < 4; ++m) { const int row = u.pm * BM + ai * HALF + wr * 64 + m * 16 + fr;
            const size_t off = (size_t)row * DM + col0;
            float q = 0.f;
#pragma unroll
            for (int bj = 0; bj < 2; ++bj) { f32x4 b[2];
#pragma unroll
                for (int n = 0; n < 2; ++n) { b[n] = acc[ai][bj][m][n] * alpha;
                    q += (b[n][0] * b[n][0] + b[n][1] * b[n][1]) + (b[n][2] * b[n][2] + b[n][3] * b[n][3]); }
                u32x4 w; w.x = pg8::cvt_pk_bf16(b[0][0], b[0][1]); w.y = pg8::cvt_pk_bf16(b[0][2], b[0][3]); w.z = pg8::cvt_pk_bf16(b[1][0], b[1][1]); w.w = pg8::cvt_pk_bf16(b[1][2], b[1][3]);
                *(GAS u32x4*)(xb + off + bj * HALF) = w; }
            q += __int_as_float(__builtin_amdgcn_ds_swizzle(__float_as_int(q), 0x1f | (16 << 10)));
            { auto rr = __builtin_amdgcn_permlane32_swap(__float_as_uint(q), __float_as_uint(q), false, false); q = __uint_as_float(rr[0]) + __uint_as_float(rr[1]); }
            if (fq == 0) __hip_atomic_fetch_add(ssacc + row, (unsigned long long)(q * SS_FIX + 0.5f), __ATOMIC_RELAXED, __HIP_MEMORY_SCOPE_AGENT);
        }
    }
};


__global__ void __launch_bounds__(NWAVES * 64, 2) enc_fwd(Args args) {
    extern __shared__ __attribute__((aligned(16))) unsigned char lds[];
    LAS unsigned char* const L = (LAS unsigned char*)lds;
    volatile LAS unsigned* MISC = (volatile LAS unsigned*)(L + MISC_OFF);
    const int wave0 = __builtin_amdgcn_readfirstlane(threadIdx.x >> 6);
#define LANE_SETUP() int G = gridDim.x, bx = blockIdx.x; asm volatile("" : "+s"(G), "+s"(bx)); const int vcu = (G % 8 == 0) ? (bx % 8) * (G / 8) + bx / 8 : bx; const int NGW = G * NWAVES; (void)NGW; int lane_; asm volatile("v_mbcnt_lo_u32_b32 %0, -1, 0\n\tv_mbcnt_hi_u32_b32 %0, -1, %0" : "=v"(lane_)); int wave = wave0; asm volatile("" : "+s"(wave)); const int lane = lane_, tid = wave * 64 + lane; (void)tid; const int gw = vcu * NWAVES + wave; (void)lane; (void)gw
    gu32* ctl = (gu32*)(args.ws + WS_CTL);
#define Hb ((bf16*)(GAS bf16*)(ws + WS_H))
#define SSACC(i) ((unsigned long long*)(GAS unsigned long long*)(ws + WS_SSACC) + (size_t)(i) * M)
#define SSFFA(i) ((unsigned long long*)(GAS unsigned long long*)(ws + WS_SSFFA) + (size_t)(i) * M)
#define Zb ((bf16*)(GAS bf16*)(ws + WS_Z))
#define HID ((bf16*)(GAS bf16*)(ws + WS_Z))
#define QN ((bf16*)(GAS bf16*)(ws + WS_QN))
#define KN ((bf16*)(GAS bf16*)(ws + WS_KN))
#define VN ((bf16*)(GAS bf16*)(ws + WS_VN))
#define ZT ((bf16*)(GAS bf16*)(ws + WS_ZT))
#define MB ((bf16*)(GAS bf16*)(ws + WS_ZT))
#define Fb ((bf16*)(GAS bf16*)(ws + WS_F))
#define Ob ((bf16*)(GAS bf16*)(ws + WS_O))
#define ROPE ((float*)(GAS float*)(ws + WS_ROPE))
#define DFTC ((bf16*)(GAS bf16*)(ws + WS_DFTC))
#define WBIG ((bf16*)(GAS bf16*)(ws + WS_WBIG))
#define W2P ((bf16*)(GAS bf16*)(ws + WS_W2P))
#define TWT ((float*)(GAS float*)(ws + WS_TW))
#define Y2b ((bf16*)(GAS bf16*)(ws + WS_Y2))
#define x_in (args.in[0])
#define xo   (args.out)
#define PH_SETUP() GAS unsigned char* ws = (GAS unsigned char*)args.ws; asm volatile("" : "+s"(ws)); int layer = hl >> 1; asm volatile("" : "+s"(layer)); GAS unsigned char* wl = ws + WS_W + (size_t)layer * W_LAYER; (void)wl; LANE_SETUP()
    for (int u = threadIdx.x; u < (LDS_BYTES - LDSCTL_OFF) / 4; u += NWAVES * 64) ((LAS unsigned*)(L + LDSCTL_OFF))[u] = 0u;
    __syncthreads();
    XcdBarrier bar; bar.bar = (unsigned*)(ctl + CW_BAR); bar.x = 0; bar.st = nullptr;
    if (MK_ONE_LAUNCH) bar = xcd_barrier_post((unsigned*)(ctl + CW_BAR), MISC + 8);
    const int lo = args.ph_lo, hi = args.ph_hi;
    int ph = 0;
#define IN_PH() (lo <= ph && ph < hi)
#define END_PH() do { if (MK_ONE_LAUNCH && lo <= ph && ph + 1 < hi) xcd_barrier(bar); ++ph; } while (0)

    if (IN_PH()) { {
        GAS unsigned char* ws = (GAS unsigned char*)args.ws; asm volatile("" : "+s"(ws)); LANE_SETUP();
        LAS float* scr = (LAS float*)(L + RING_OFF + wave * 16384);
        constexpr int I_G = (DM / 64) * (DFF / 32), I_D = (DFF / 64) * (DM / 32), I_IN = (DM / 64) * (DIN / 32), I_P = (DFOUR / 64) * (DM / 32), I_O = (DM / 64) * (DM / 32);
        constexpr int C1 = I_G, C2 = C1 + I_G, C3 = C2 + I_D, C4 = C3 + I_IN, C5 = C4 + I_P, C6 = C5 + I_P, C7 = C6 + I_O, C8 = C7 + I_G, C9 = C8 + I_G, C10 = C9 + I_D;
        for (int layer = 0; layer < DEPTH; ++layer) {
            GAS unsigned char* wl = ws + WS_W + (size_t)layer * W_LAYER;
            const float* gate_a = args.in[2] + (size_t)layer * DM * DFF; const float* up_a = args.in[3] + (size_t)layer * DM * DFF; const float* down_a = args.in[4] + (size_t)layer * DFF * DM;
            const float* w_in = args.in[6] + (size_t)layer * DM * DIN; const float* p_f = args.in[14] + (size_t)layer * DFOUR * DM; const float* p_a = args.in[15] + (size_t)layer * DFOUR * DM;
            const float* w_o = args.in[16] + (size_t)layer * DM * DM;
            const float* gate_b = args.in[18] + (size_t)layer * DM * DFF; const float* up_b = args.in[19] + (size_t)layer * DM * DFF; const float* down_b = args.in[20] + (size_t)layer * DFF * DM;
            for (int it = gw; it < C10; it += NGW) {
                if (it < C1)      transpose_item(gate_a, DM, DFF, (bf16*)(wl + WL_GUA), 1, scr, it, lane, args.in[1] + (size_t)layer * DM);
                else if (it < C2) transpose_item(up_a, DM, DFF, (bf16*)(wl + WL_GUA), 2, scr, it - C1, lane, args.in[1] + (size_t)layer * DM);
                else if (it < C3) transpose_item(down_a, DFF, DM, (bf16*)(wl + WL_DA), 0, scr, it - C2, lane);
                else if (it < C4) transpose_item(w_in, DM, DIN, (bf16*)(wl + WL_IN), 3, scr, it - C3, lane, args.in[5] + (size_t)layer * DM);
                else if (it < C5) transpose_item(p_f, DFOUR, DM, (bf16*)(wl + WL_PF), 0, scr, it - C4, lane);
                else if (it < C6) transpose_item(p_a, DFOUR, DM, (bf16*)(wl + WL_PA), 0, scr, it - C5, lane);
                else if (it < C7) transpose_item(w_o, DM, DM, (bf16*)(wl + WL_WO), 0, scr, it - C6, lane);
                else if (it < C8) transpose_item(gate_b, DM, DFF, (bf16*)(wl + WL_GUB), 1, scr, it - C7, lane, args.in[17] + (size_t)layer * DM);
                else if (it < C9) transpose_item(up_b, DM, DFF, (bf16*)(wl + WL_GUB), 2, scr, it - C8, lane, args.in[17] + (size_t)layer * DM);
                else              transpose_item(down_b, DFF, DM, (bf16*)(wl + WL_DB), 0, scr, it - C9, lane);
            }
        }
        const int gt = (vcu * NWAVES + wave) * 64 + lane, NGT = NGW * 64;
        for (int i = gt; i < 256 * 256; i += NGT) { const int r = i >> 8, c = i & 255, pr = r >> 7, s1p = r & 127, pc = c >> 7, s1 = c & 127, j = (s1 * s1p) & 127;
            float sn, cs; sincospif((float)j * (1.0f / 64.0f), &sn, &cs); WBIG[i] = (bf16)f2bf(pr == pc ? cs : (pr ? sn : -sn)); }
        for (int i = gt; i < 256 * 128; i += NGT) { const int r = i >> 7, c = i & 127, pc = c >> 6, s2 = c & 63, j = (s2 * r) & 63;
            float sn, cs; sincospif((float)j * (1.0f / 32.0f), &sn, &cs); W2P[i] = (bf16)f2bf(r < 64 ? (pc ? -sn : cs) : 0.0f); }
        for (int i = gt; i < 128 * 64; i += NGT) { const int s1p = i >> 6, s2 = i & 63; float sn, cs; sincospif((float)(s1p * s2) * (1.0f / 4096.0f), &sn, &cs); TWT[2 * i] = cs; TWT[2 * i + 1] = sn; }
        for (int i = gt; i < 512 * 256; i += NGT) { const int r = i >> 8, c = i & 255, part = r >> 8, cp = r & 255, j = (c * cp) & 255;
            float sn, cs; sincospif((float)j * (1.0f / 128.0f), &sn, &cs); DFTC[i] = (bf16)f2bf((part ? sn : cs) * 0.0625f); }
        for (int i = gt; i < SEQ * 8; i += NGT) { const int s = i >> 3, j = i & 7;
            const double inv = j == 0 ? 1.0 : j == 1 ? 0.19392274474868576 : j == 2 ? 0.03760603093086393 : j == 3 ? 0.007292664737217109 : j == 4 ? 0.001414213562373095 : j == 5 ? 0.0002742481756762073 : j == 6 ? 5.318295896944988e-05 : 1.031338537721246e-05;
            const double rev = (double)s * inv * 0.15915494309189535;
            const float fr = (float)(rev - __builtin_rint(rev)); float sn, cs; sincospif(2.0f * fr, &sn, &cs);
            ROPE[s * 16 + j] = cs; ROPE[s * 16 + 8 + j] = sn; }
        for (int m = gw; m < M; m += NGW) { const float ssq = row_to_bf16_ss(x_in + (size_t)m * DM, Hb + (size_t)m * DM, lane); if (lane == 0) SSFFA(0)[m] = (unsigned long long)(ssq * SS_FIX + 0.5f); }
    } }
    END_PH();

    for (int hl = 0; hl < 2 * DEPTH; ++hl) {
        const int ff = hl & 1;
        if (IN_PH()) { PH_SETUP();
            pg8::Prob g = pg8::mk_prob(Hb, (const char*)(wl + (ff ? WL_GUB : WL_GUA)), DM * 2, DM * 2, 0, 0, DM);
            pg8::GridOrder S; S.init(M / 256, 2 * DFF / 256, 1, G, bx);
            pg8::EpiSwiglu E{HID, DFF, ff ? SSACC(2 * layer + 1) : SSFFA(layer)};
            pg8::gemm_phase<pg8::EpiSwiglu, pg8::GridOrder, true>(L + RING_OFF, g, S, E, tid);
        }
        END_PH();
        if (IN_PH()) { PH_SETUP();
            pg8::Prob g = pg8::mk_prob(HID, (const char*)(wl + (ff ? WL_DB : WL_DA)), DFF * 2, DFF * 2, 0, 0, DFF);
            pg8::GridOrder S; S.init(M / 256, DM / 256, 1, G, bx, 4);
            if (ff == 0) {
                EpiResid<1> E{&args, hl == 0, (unsigned)(WS_SSACC + (size_t)(2 * layer) * M * 8)};
                pg8::gemm_phase<EpiResid<1>, pg8::GridOrder, true>(L + RING_OFF, g, S, E, tid);
            } else {
                pg8::EpiBf16 E{Y2b, DM, 1.0f, 0, nullptr};
                pg8::gemm_phase<pg8::EpiBf16, pg8::GridOrder, true>(L + RING_OFF, g, S, E, tid);
            }
        }
        END_PH();
        if (ff == 0) {
            if (IN_PH()) { PH_SETUP();
                pg8::Prob g = pg8::mk_prob(Hb, (const char*)(wl + WL_IN), DM * 2, DM * 2, 0, 0, DM);
                pg8::GridOrder S; S.init(M / 256, DIN / 256, 1, G, bx);
                EpiWin E{&args, SSACC(2 * layer), args.in[7] + (size_t)layer * QKD, args.in[8] + (size_t)layer * QKD};
                pg8::gemm_phase<EpiWin, pg8::GridOrder, true>(L + RING_OFF, g, S, E, tid);
            }
            END_PH();
            if (IN_PH()) { PH_SETUP();
                pg8::Prob g = pg8::mk_prob(DFTC, (Zb + ZC_UF), 256 * 2, 64 * DIN * 2, 0, 256 * 2, 256);
                g.hsB = DIN * 2; g.m0 = 31u; g.s0 = (size_t)2 * DIN * 2; g.sh1 = 5; g.m1 = 1u; g.s1 = (size_t)SEQ * DIN * 2; g.sh2 = 31; g.s2 = 0;
                pg8::GridOrder S; S.init(2, M / 256, 4, G, bx);
                pg8::EpiCstep E{ZT};
                pg8::gemm_phase<pg8::EpiCstep, pg8::GridOrder, true>(L + RING_OFF, g, S, E, tid);
            }
            END_PH();
            if (IN_PH()) { PH_SETUP();
                pg8::Prob g = pg8::mk_prob(WBIG, ZT, 256 * 2, 256 * 2, 0, 0, 256);
                pg8::GridOrder S; S.init(1, (1024 * 2 * 64) / 256, 1, G, bx);
                pg8::EpiS1 E{Y2b, TWT};
                pg8::gemm_phase<pg8::EpiS1, pg8::GridOrder, true>(L + RING_OFF, g, S, E, tid);
            }
            END_PH();
            if (IN_PH()) { PH_SETUP();
                float lam, negshift;
                { const float a = args.in[9][layer * QKD + lane] * args.in[10][layer * QKD + lane], b = args.in[11][layer * QKD + lane] * args.in[12][layer * QKD + lane];
                  const float lam_init = 0.8f - 0.6f * expf(-0.3f * (float)layer);
                  lam = expf(wave_sum(a)) - expf(wave_sum(b)) + lam_init; lam = __builtin_bit_cast(float, __builtin_amdgcn_readfirstlane(__builtin_bit_cast(int, lam)));
                  const float mq = wave_max(fabsf(args.in[7][layer * QKD + lane])), mk = wave_max(fabsf(args.in[8][layer * QKD + lane]));
                  const float bound = 8.0f * 1.4426950408889634f * mq * mk;
                  negshift = -fminf(bound, 60.0f); negshift = __builtin_bit_cast(float, __builtin_amdgcn_readfirstlane(__builtin_bit_cast(int, negshift))); }
                const bool noshift = negshift > -60.0f;
                const float lam_init = __builtin_bit_cast(float, __builtin_amdgcn_readfirstlane(__builtin_bit_cast(int, 0.8f - 0.6f * expf(-0.3f * (float)layer))));
                const float* gsub = args.in[13] + (size_t)layer * VD;
                for (int i = 0; i < 4; ++i) {
                    if (G != 256) break;
                    const int bh = (vcu >> 5) + 8 * (i >> 1), qb = (i & 1) * 32 + (vcu & 31), b = bh >> 3, h = bh & 7;
                    const size_t row0 = (size_t)b * SEQ, hb = (size_t)bh * SEQ * 128;
                    if (noshift) att::attn_unit<false>(QN + hb + (size_t)qb * 128 * 128, KN + hb, VN + hb, Ob + (row0 + qb * 128) * 1024 + h * 128,
                                   SEQ, negshift, lam, gsub, 1.0f - lam_init, EPS, (att::lptr)(L + RING_OFF), wave);
                    else         att::attn_unit<true>(QN + hb + (size_t)qb * 128 * 128, KN + hb, VN + hb, Ob + (row0 + qb * 128) * 1024 + h * 128,
                                   SEQ, negshift, lam, gsub, 1.0f - lam_init, EPS, (att::lptr)(L + RING_OFF), wave);
                }
                pg8::Prob g = pg8::mk_prob(W2P, Y2b, 128 * 2, 2 * 128 * 2, 0, 0, 128);
                g.m0 = 3u; g.s0 = (size_t)256 * 512; g.sh1 = 2; g.m1 = 127u; g.s1 = (size_t)1024 * 512; g.sh2 = 9; g.s2 = 256;
                pg8::GridOrder S; S.init(1, BATCH * 128 * 4, 1, G, bx);
                pg8::EpiS2 E{Fb, 0.011048543456039806f};
                int lane_b; asm volatile("v_mbcnt_lo_u32_b32 %0, -1, 0\n\tv_mbcnt_hi_u32_b32 %0, -1, %0" : "=v"(lane_b));
                pg8::gemm_phase<pg8::EpiS2, pg8::GridOrder, true>(L + RING_OFF, g, S, E, wave * 64 + lane_b);
            }
            END_PH();
            if (IN_PH()) { PH_SETUP();
                pg8::Prob g = pg8::mk_prob(Fb, (const char*)(wl + WL_PF), DFOUR * 2, DFOUR * 2, (size_t)(WS_O - WS_F), (size_t)(WL_PA - WL_PF), DFOUR);
                pg8::GridOrder S; S.init(M / 256, DM / 256, 1, G, bx, pg8::WGM, 2);
                pg8::EpiGate2 E{Zb + ZC_GF, Zb + ZC_GA, DIN, MB, DM};
                pg8::gemm_phase<pg8::EpiGate2, pg8::GridOrder, true>(L + RING_OFF, g, S, E, tid);
            }
            END_PH();
            if (IN_PH()) { PH_SETUP();
                pg8::Prob g = pg8::mk_prob(MB, (const char*)(wl + WL_WO), DM * 2, DM * 2, 0, 0, DM);
                pg8::GridOrder S; S.init(M / 256, DM / 256, 1, G, bx);
                EpiResid<2> E{&args, 0, (unsigned)(WS_SSACC + (size_t)(2 * layer + 1) * M * 8)};
                pg8::gemm_phase<EpiResid<2>, pg8::GridOrder, true>(L + RING_OFF, g, S, E, tid);
            }
            END_PH();
        } else {
            if (IN_PH()) { PH_SETUP();
                f32x4 go[8];
                const bool has_next = (layer + 1 < DEPTH);
#pragma unroll
                for (int j = 0; j < 8; ++j) go[j] = *((const GAS f32x4*)(args.in[21] + (size_t)layer * DM) + lane + 64 * j);
                for (int m = gw; m < M; m += NGW) {
                    GAS unsigned long long* xr = (GAS unsigned long long*)(Hb + (size_t)m * DM) + lane;
                    f32x4 v[8]; float s = 0.f;
#pragma unroll
                    for (int j = 0; j < 8; ++j) { const unsigned long long xw = xr[64 * j], yw = ((const GAS unsigned long long*)(Y2b + (size_t)m * DM) + lane)[64 * j];
                        v[j] = (f32x4){pg8::bf_lo((unsigned)xw), pg8::bf_hi((unsigned)xw), pg8::bf_lo((unsigned)(xw >> 32)), pg8::bf_hi((unsigned)(xw >> 32))}
                             + 0.5f * (f32x4){pg8::bf_lo((unsigned)yw), pg8::bf_hi((unsigned)yw), pg8::bf_lo((unsigned)(yw >> 32)), pg8::bf_hi((unsigned)(yw >> 32))};
                        s += (v[j].x * v[j].x + v[j].y * v[j].y) + (v[j].z * v[j].z + v[j].w * v[j].w); }
                    const float rstd = 1.f / sqrtf(wave_sum(s) * (1.f / DM) + EPS);
                    float s2 = 0.f;
#pragma unroll
                    for (int j = 0; j < 8; ++j) { v[j] = v[j] * rstd * go[j]; s2 += (v[j].x * v[j].x + v[j].y * v[j].y) + (v[j].z * v[j].z + v[j].w * v[j].w); }
                    if (has_next) {
                        const float ss2 = wave_sum(s2);
#pragma unroll
                        for (int j = 0; j < 8; ++j) xr[64 * j] = (unsigned long long)pk2(v[j].x, v[j].y) | ((unsigned long long)pk2(v[j].z, v[j].w) << 32);
                        if (lane == 0) SSFFA(layer + 1)[m] = (unsigned long long)(ss2 * SS_FIX + 0.5f);
                    } else {
                        GAS f32x4* orow = (GAS f32x4*)(xo + (size_t)m * DM) + lane;
#pragma unroll
                        for (int j = 0; j < 8; ++j) orow[64 * j] = v[j];
                    }
                }
            }
            END_PH();
        }
    }
#undef IN_PH
#undef END_PH
}

constexpr int N_PHASES = 1 + DEPTH * (2 + 6 + 2 + 1);

extern "C" void kernel_launch(void* const* d_in, const int* in_sizes, int n_in, void* d_out, int out_size, void* d_ws, size_t ws_size, hipStream_t stream) {
    static int grid = 0;
    if (grid == 0) {
        if (n_in != 22 || in_sizes[0] != M * DM || out_size != M * DM || ws_size < WS_END) {
            fprintf(stderr, "kernel_launch: shape/workspace mismatch: n_in %d in0 %d out %d ws %zu (need %zu); nothing launched\n", n_in, n_in > 0 ? in_sizes[0] : -1, out_size, ws_size, (size_t)WS_END); grid = -1; return; }
        int dev = 0, cus = 0;
        if (hipGetDevice(&dev) != hipSuccess || hipDeviceGetAttribute(&cus, hipDeviceAttributeMultiprocessorCount, dev) != hipSuccess) { fprintf(stderr, "kernel_launch: device query failed\n"); grid = -1; return; }
        if (hipFuncSetAttribute((const void*)enc_fwd, hipFuncAttributeMaxDynamicSharedMemorySize, LDS_BYTES) != hipSuccess) { fprintf(stderr, "kernel_launch: hipFuncSetAttribute failed\n"); grid = -1; return; }
        int per_cu = 0;
        if (hipOccupancyMaxActiveBlocksPerMultiprocessor(&per_cu, (const void*)enc_fwd, NWAVES * 64, LDS_BYTES) != hipSuccess || per_cu < 1)
            fprintf(stderr, "kernel_launch: note: occupancy query reports %d workgroups per CU\n", per_cu);
        (void)hipGetLastError();
        grid = cus;
        if (grid != 256) fprintf(stderr, "kernel_launch: %d CUs; the attention phase assumes 256\n", grid);
    }
    if (grid < 0) return;
    if (hipMemsetAsync((char*)d_ws + WS_CTL, 0, CTL_ZERO_BYTES, stream) != hipSuccess) { fprintf(stderr, "kernel_launch: memset failed\n"); return; }
    Args a{};
    for (int i = 0; i < 22; ++i) a.in[i] = (const float*)d_in[i];
    a.out = (float*)d_out; a.ws = (unsigned char*)d_ws;
#if MK_ONE_LAUNCH
    a.ph_lo = 0; a.ph_hi = N_PHASES;
    hipLaunchKernelGGL(enc_fwd, dim3(grid), dim3(NWAVES * 64), LDS_BYTES, stream, a);
#else
    for (int p = 0; p < N_PHASES; ++p) { a.ph_lo = p; a.ph_hi = p + 1; hipLaunchKernelGGL(enc_fwd, dim3(grid), dim3(NWAVES * 64), LDS_BYTES, stream, a); }
#endif
    const hipError_t le = hipPeekAtLastError();
    if (le != hipSuccess) fprintf(stderr, "kernel_launch: launch failed: %s\n", hipGetErrorName(le));
}
```

```cpp
#include <hip/hip_runtime.h>
#include <cstdio>
#include <cstdint>

#ifndef MK_ONE_LAUNCH
#define MK_ONE_LAUNCH 1
#endif

namespace pg8 {
#define PG8_LAS __attribute__((address_space(3)))
typedef unsigned short bf16_t;
typedef short bf16x8 __attribute__((ext_vector_type(8)));
typedef float f32x4 __attribute__((ext_vector_type(4)));
typedef float f32x2 __attribute__((ext_vector_type(2)));
typedef unsigned u32x4 __attribute__((ext_vector_type(4)));
constexpr int BM = 256, BK = 64, HALF = 128, HTB = HALF * BK * 2, STAGE_BYTES = 8 * HTB, NXCD = 8, WGM = 8;

__host__ __device__ __forceinline__ int lds_byte(int r, int c) { const int st = (r >> 4) * 2 + (c >> 5), rr = r & 15, cc = c & 31, ob = rr * 64 + cc * 2; return st * 1024 + (ob ^ (((ob >> 9) & 1) << 5)); }
__host__ __device__ __forceinline__ void stage_rc(int b, int& R, int& C) { const int st = b / 1024, sb = b % 1024, swz = sb ^ (((sb >> 9) & 1) << 5); R = (st >> 1) * 16 + swz / 64; C = (st & 1) * 32 + (swz % 64) / 2; }
__host__ __device__ __forceinline__ int perm32(int rho) { const int n = rho >> 4, i = rho & 15; return 8 * (i >> 2) + 4 * n + (i & 3); }

struct Unit { int pm, pn, pz; };
struct Prob { const char* A; const char* B; unsigned lda, ldb; size_t sAz, sBz; int K;
              unsigned hsB; int sh1, sh2; unsigned m0, m1; size_t s0, s1, s2;
    __device__ __forceinline__ const char* bbase(const Unit& u) const { return B + (size_t)u.pz * sBz + (size_t)((unsigned)u.pn & m0) * s0 + (size_t)(((unsigned)u.pn >> sh1) & m1) * s1 + (size_t)((unsigned)u.pn >> sh2) * s2; } };
__device__ __forceinline__ Prob mk_prob(const void* A, const void* B, unsigned lda, unsigned ldb, size_t sAz, size_t sBz, int K) {
    Prob p; p.A = (const char*)A; p.B = (const char*)B; p.lda = lda; p.ldb = ldb; p.sAz = sAz; p.sBz = sBz; p.K = K; p.hsB = HALF * ldb; p.sh1 = 0; p.sh2 = 31; p.m0 = 0x7fffffffu; p.m1 = 0u; p.s0 = (size_t)BM * ldb; p.s1 = 0; p.s2 = 0; return p; }

struct GridOrder {
    int nM, nN, nZ, nwg, G, c, wgm, seg;
    __device__ void init(int nM_, int nN_, int nZ_, int G_, int c_, int wgm_ = WGM, int seg_ = 1) { nM = nM_; nN = nN_; nZ = nZ_; nwg = nM * nN; G = G_; c = c_; wgm = wgm_; seg = seg_; }
    __device__ bool next(int i, Unit& u) const {
        const long L = (seg == 2) ? (long)(i >> 1) * G + c : (long)i * G + c; if (L >= (long)nwg * nZ) return false;
        u.pz = (seg == 2) ? (i & 1) : (int)(L / nwg);
        int wgid = (int)(L % nwg); { const int q = nwg / NXCD, r = nwg % NXCD, xcd = wgid % NXCD, off = wgid / NXCD; wgid = (xcd < r ? xcd * (q + 1) : r * (q + 1) + (xcd - r) * q) + off; }
        const int nig = wgm * nN, gid = wgid / nig, fm = gid * wgm, gsz = (nM - fm) < wgm ? (nM - fm) : wgm;
        u.pm = fm + ((wgid % nig) % gsz); u.pn = (wgid % nig) / gsz; return true;
    }
};

typedef __bf16 cv_bf16x2 __attribute__((ext_vector_type(2)));
typedef float cv_f32x2 __attribute__((ext_vector_type(2)));
__device__ __forceinline__ unsigned cvt_pk_bf16(float lo, float hi) { const cv_f32x2 v = {lo, hi}; return __builtin_bit_cast(unsigned, __builtin_convertvector(v, cv_bf16x2)); }
__device__ __forceinline__ float bf_lo(unsigned w) { return __uint_as_float(w << 16); }
__device__ __forceinline__ float bf_hi(unsigned w) { return __uint_as_float(w & 0xffff0000u); }
__device__ __forceinline__ float sigmoidf_(float x) { return __builtin_amdgcn_rcpf(1.0f + __builtin_amdgcn_exp2f(-1.4426950408889634f * x)); }

#define EPI_ROWS_BEGIN _Pragma("unroll") for (int ai = 0; ai < 2; ++ai) _Pragma("unroll") for (int m = 0; m < 4; ++m) { const int row = u.pm * BM + ai * HALF + wr * 64 + m * 16 + fr;
#define EPI_ROWS_END }

struct EpiBf16 {
    struct State { float rs[8]; };
    bf16_t* O; int ldc; float scale; int zrows; const unsigned long long* ss;
    __device__ __forceinline__ void init(f32x4 (&acc)[2][2][4][2], State& st, const Unit& u, int wr, int, int fr, int) const {
        if (ss) {
#pragma unroll
            for (int ai = 0; ai < 2; ++ai)
#pragma unroll
                for (int m = 0; m < 4; ++m) st.rs[ai * 4 + m] = __builtin_amdgcn_rsqf((float)ss[u.pm * BM + ai * HALF + wr * 64 + m * 16 + fr] * (1.0f / (1048576.0f * 2048.0f)) + 1e-6f); }

#pragma unroll
        for (int a = 0; a < 2; ++a)
#pragma unroll
            for (int b = 0; b < 2; ++b)
#pragma unroll
                for (int m = 0; m < 4; ++m)
#pragma unroll
                    for (int n = 0; n < 2; ++n) acc[a][b][m][n] = (f32x4){0.f, 0.f, 0.f, 0.f}; }
    __device__ __forceinline__ void operator()(const f32x4 (&acc)[2][2][4][2], const State& st, const Unit& u, int wr, int wc, int fr, int fq) const {
        const int col0 = u.pn * BM + wc * 32 + 8 * fq;
        EPI_ROWS_BEGIN
            bf16_t* rowp = O + (size_t)(u.pz * zrows + row) * ldc + col0;
            const float rs = ss ? scale * st.rs[ai * 4 + m] : scale;
#pragma unroll
            for (int bj = 0; bj < 2; ++bj) { const f32x4 v0 = acc[ai][bj][m][0] * rs, v1 = acc[ai][bj][m][1] * rs;
                u32x4 w; w.x = cvt_pk_bf16(v0[0], v0[1]); w.y = cvt_pk_bf16(v0[2], v0[3]); w.z = cvt_pk_bf16(v1[0], v1[1]); w.w = cvt_pk_bf16(v1[2], v1[3]);
                *(u32x4*)(rowp + bj * HALF) = w; }
        EPI_ROWS_END
    }
};
struct EpiSwiglu {
    struct State { float rs[8]; };
    bf16_t* O; int ldc; const unsigned long long* ss;
    __device__ __forceinline__ void init(f32x4 (&acc)[2][2][4][2], State& st, const Unit& u, int wr, int, int fr, int) const {
        {
#pragma unroll
            for (int ai = 0; ai < 2; ++ai)
#pragma unroll
                for (int m = 0; m < 4; ++m) st.rs[ai * 4 + m] = __builtin_amdgcn_rsqf((float)ss[u.pm * BM + ai * HALF + wr * 64 + m * 16 + fr] * (1.0f / (1048576.0f * 2048.0f)) + 1e-6f); }

#pragma unroll
        for (int a = 0; a < 2; ++a)
#pragma unroll
            for (int b = 0; b < 2; ++b)
#pragma unroll
                for (int m = 0; m < 4; ++m)
#pragma unroll
                    for (int n = 0; n < 2; ++n) acc[a][b][m][n] = (f32x4){0.f, 0.f, 0.f, 0.f}; }
    __device__ __forceinline__ void operator()(const f32x4 (&acc)[2][2][4][2], const State& st, const Unit& u, int wr, int wc, int fr, int fq) const {
        const int col0 = u.pn * HALF + wc * 32 + 8 * fq;
        EPI_ROWS_BEGIN
            const float rs = st.rs[ai * 4 + m];
            float h[8];
#pragma unroll
            for (int n = 0; n < 2; ++n)
#pragma unroll
                for (int e = 0; e < 4; ++e) { const float g = acc[ai][0][m][n][e] * rs, up = acc[ai][1][m][n][e] * rs; h[n * 4 + e] = g * sigmoidf_(g) * up; }
            u32x4 w; w.x = cvt_pk_bf16(h[0], h[1]); w.y = cvt_pk_bf16(h[2], h[3]); w.z = cvt_pk_bf16(h[4], h[5]); w.w = cvt_pk_bf16(h[6], h[7]);
            *(u32x4*)(O + (size_t)row * ldc + col0) = w;
        EPI_ROWS_END
    }
};
struct EpiGate {
    struct State { float rs[8]; };
    const bf16_t* G; int ldg; const bf16_t* T; bf16_t* O; int ldc; int add;
    __device__ __forceinline__ void init(f32x4 (&acc)[2][2][4][2], State&, const Unit&, int, int, int, int) const {
#pragma unroll
        for (int a = 0; a < 2; ++a)
#pragma unroll
            for (int b = 0; b < 2; ++b)
#pragma unroll
                for (int m = 0; m < 4; ++m)
#pragma unroll
                    for (int n = 0; n < 2; ++n) acc[a][b][m][n] = (f32x4){0.f, 0.f, 0.f, 0.f}; }
    __device__ __forceinline__ void operator()(const f32x4 (&acc)[2][2][4][2], const State& st, const Unit& u, int wr, int wc, int fr, int fq) const {
        const int col0 = u.pn * BM + wc * 32 + 8 * fq;
        EPI_ROWS_BEGIN
#pragma unroll
            for (int bj = 0; bj < 2; ++bj) {
                const u32x4 gw = *(const u32x4*)(G + (size_t)row * ldg + col0 + bj * HALF);
                u32x4 tw = (u32x4){0u, 0u, 0u, 0u};
                if (add) tw = *(const u32x4*)(T + (size_t)row * ldc + col0 + bj * HALF);
                float r[8];
#pragma unroll
                for (int q = 0; q < 4; ++q) {
                    const float a0 = acc[ai][bj][m][q >> 1][(q & 1) * 2], a1 = acc[ai][bj][m][q >> 1][(q & 1) * 2 + 1];
                    r[2 * q] = bf_lo(tw[q]) + sigmoidf_(bf_lo(gw[q])) * a0; r[2 * q + 1] = bf_hi(tw[q]) + sigmoidf_(bf_hi(gw[q])) * a1; }
                u32x4 w; w.x = cvt_pk_bf16(r[0], r[1]); w.y = cvt_pk_bf16(r[2], r[3]); w.z = cvt_pk_bf16(r[4], r[5]); w.w = cvt_pk_bf16(r[6], r[7]);
                *(u32x4*)(O + (size_t)row * ldc + col0 + bj * HALF) = w; }
        EPI_ROWS_END
    }
};
struct EpiGate2 {
    struct State { float rs[8]; };
    const bf16_t* Gf; const bf16_t* Ga; int ldg; bf16_t* O; int ldc;
    __device__ __forceinline__ void init(f32x4 (&acc)[2][2][4][2], State&, const Unit& u, int, int, int, int) const {
        if (u.pz != 0) return;
#pragma unroll
        for (int a = 0; a < 2; ++a)
#pragma unroll
            for (int b = 0; b < 2; ++b)
#pragma unroll
                for (int m = 0; m < 4; ++m)
#pragma unroll
                    for (int n = 0; n < 2; ++n) acc[a][b][m][n] = (f32x4){0.f, 0.f, 0.f, 0.f}; }
    __device__ __forceinline__ void operator()(f32x4 (&acc)[2][2][4][2], const State& st, const Unit& u, int wr, int wc, int fr, int fq) const {
        const int col0 = u.pn * BM + wc * 32 + 8 * fq;
        EPI_ROWS_BEGIN
#pragma unroll
            for (int bj = 0; bj < 2; ++bj) {
                const u32x4 ga = *(const u32x4*)(Ga + (size_t)row * ldg + col0 + bj * HALF);
                if (u.pz == 0) {
                    const u32x4 gf = *(const u32x4*)(Gf + (size_t)row * ldg + col0 + bj * HALF);
#pragma unroll
                    for (int q = 0; q < 4; ++q) {
                        const float e0 = __builtin_amdgcn_exp2f(-1.4426950408889634f * bf_lo(ga[q])), e1 = __builtin_amdgcn_exp2f(-1.4426950408889634f * bf_hi(ga[q]));
                        const float f0 = __builtin_amdgcn_exp2f(-1.4426950408889634f * bf_lo(gf[q])), f1 = __builtin_amdgcn_exp2f(-1.4426950408889634f * bf_hi(gf[q]));
                        acc[ai][bj][m][q >> 1][(q & 1) * 2] *= (1.0f + e0) * __builtin_amdgcn_rcpf(1.0f + f0);
                        acc[ai][bj][m][q >> 1][(q & 1) * 2 + 1] *= (1.0f + e1) * __builtin_amdgcn_rcpf(1.0f + f1); }
                } else {
                    float r[8];
#pragma unroll
                    for (int q = 0; q < 4; ++q) { r[2 * q] = sigmoidf_(bf_lo(ga[q])) * acc[ai][bj][m][q >> 1][(q & 1) * 2]; r[2 * q + 1] = sigmoidf_(bf_hi(ga[q])) * acc[ai][bj][m][q >> 1][(q & 1) * 2 + 1]; }
                    u32x4 w; w.x = cvt_pk_bf16(r[0], r[1]); w.y = cvt_pk_bf16(r[2], r[3]); w.z = cvt_pk_bf16(r[4], r[5]); w.w = cvt_pk_bf16(r[6], r[7]);
                    *(u32x4*)(O + (size_t)row * ldc + col0 + bj * HALF) = w; }
            }
        EPI_ROWS_END
    }
};
struct EpiCstep {
    struct State { float rs[8]; };
    bf16_t* X1;
    __device__ __forceinline__ void init(f32x4 (&acc)[2][2][4][2], State&, const Unit&, int, int, int, int) const {
#pragma unroll
        for (int a = 0; a < 2; ++a)
#pragma unroll
            for (int b = 0; b < 2; ++b)
#pragma unroll
                for (int m = 0; m < 4; ++m)
#pragma unroll
                    for (int n = 0; n < 2; ++n) acc[a][b][m][n] = (f32x4){0.f, 0.f, 0.f, 0.f}; }
    __device__ __forceinline__ void operator()(const f32x4 (&acc)[2][2][4][2], const State& st, const Unit& u, int wr, int wc, int fr, int fq) const {
        const int b = u.pn >> 5, s1_0 = wc * 32 + 8 * fq;
        EPI_ROWS_BEGIN
            const int gc = u.pz * 256 + (row - u.pm * BM);
#pragma unroll
            for (int bj = 0; bj < 2; ++bj) { const int s2 = 2 * (u.pn & 31) + bj;
                const f32x4 v0 = acc[ai][bj][m][0], v1 = acc[ai][bj][m][1];
                u32x4 w; w.x = cvt_pk_bf16(v0[0], v0[1]); w.y = cvt_pk_bf16(v0[2], v0[3]); w.z = cvt_pk_bf16(v1[0], v1[1]); w.w = cvt_pk_bf16(v1[2], v1[3]);
                *(u32x4*)(X1 + ((size_t)((((gc * 2 + b) * 64 + s2) * 2 + u.pm) * 128) + s1_0)) = w; }
        EPI_ROWS_END
    }
};
struct EpiS1 {
    struct State { float rs[8]; };
    bf16_t* Y2; const float* TW;
    __device__ __forceinline__ void init(f32x4 (&acc)[2][2][4][2], State&, const Unit&, int, int, int, int) const {
#pragma unroll
        for (int a = 0; a < 2; ++a)
#pragma unroll
            for (int b = 0; b < 2; ++b)
#pragma unroll
                for (int m = 0; m < 4; ++m)
#pragma unroll
                    for (int n = 0; n < 2; ++n) acc[a][b][m][n] = (f32x4){0.f, 0.f, 0.f, 0.f}; }
    __device__ __forceinline__ void operator()(const f32x4 (&acc)[2][2][4][2], const State& st, const Unit& u, int wr, int wc, int fr, int fq) const {
        const int s2_0 = (wc & 1) * 32 + 8 * fq;
#pragma unroll
        for (int m = 0; m < 4; ++m) {
            const int s1p = wr * 64 + m * 16 + fr;
            const f32x4* tp = (const f32x4*)(TW + ((size_t)s1p * 64 + s2_0) * 2);
            const f32x4 t0 = tp[0], t1 = tp[1], t2 = tp[2], t3 = tp[3];
            const float tc[8] = {t0[0], t0[2], t1[0], t1[2], t2[0], t2[2], t3[0], t3[2]}, ts[8] = {t0[1], t0[3], t1[1], t1[3], t2[1], t2[3], t3[1], t3[3]};
#pragma unroll
            for (int bj = 0; bj < 2; ++bj) {
                const int q = u.pn * 4 + bj * 2 + (wc >> 1);
                float yr[8], yi[8];
#pragma unroll
                for (int e = 0; e < 8; ++e) { const float a = acc[0][bj][m][e >> 2][e & 3], c = acc[1][bj][m][e >> 2][e & 3]; yr[e] = a * tc[e] - c * ts[e]; yi[e] = a * ts[e] + c * tc[e]; }
                u32x4 w0, w1;
                w0.x = cvt_pk_bf16(yr[0], yr[1]); w0.y = cvt_pk_bf16(yr[2], yr[3]); w0.z = cvt_pk_bf16(yr[4], yr[5]); w0.w = cvt_pk_bf16(yr[6], yr[7]);
                w1.x = cvt_pk_bf16(yi[0], yi[1]); w1.y = cvt_pk_bf16(yi[2], yi[3]); w1.z = cvt_pk_bf16(yi[4], yi[5]); w1.w = cvt_pk_bf16(yi[6], yi[7]);
                bf16_t* dst = Y2 + ((size_t)(s1p * 2048 + q) * 2) * 64 + s2_0;
                *(u32x4*)dst = w0; *(u32x4*)(dst + 64) = w1; }
        }
    }
};
struct EpiS2 {
    struct State { float rs[8]; };
    bf16_t* F; float scale;
    __device__ __forceinline__ void init(f32x4 (&acc)[2][2][4][2], State&, const Unit&, int, int, int, int) const {
#pragma unroll
        for (int a = 0; a < 2; ++a)
#pragma unroll
            for (int b = 0; b < 2; ++b)
#pragma unroll
                for (int m = 0; m < 4; ++m)
#pragma unroll
                    for (int n = 0; n < 2; ++n) acc[a][b][m][n] = (f32x4){0.f, 0.f, 0.f, 0.f}; }
    __device__ __forceinline__ void operator()(const f32x4 (&acc)[2][2][4][2], const State& st, const Unit& u, int wr, int wc, int fr, int fq) const {
        if (wr != 0) return;
        const int gt = u.pn & 3, s1p = (u.pn >> 2) & 127, b = u.pn >> 9;
        const int col0 = gt * 256 + wc * 32 + 8 * fq;
#pragma unroll
        for (int m = 0; m < 4; ++m) { const int s2p = m * 16 + fr;
            bf16_t* rowp = F + (size_t)(b * 8192 + s1p + 128 * s2p) * 1024 + col0;
#pragma unroll
            for (int bj = 0; bj < 2; ++bj) { const f32x4 v0 = acc[0][bj][m][0] * scale, v1 = acc[0][bj][m][1] * scale;
                u32x4 w; w.x = cvt_pk_bf16(v0[0], v0[1]); w.y = cvt_pk_bf16(v0[2], v0[3]); w.z = cvt_pk_bf16(v1[0], v1[1]); w.w = cvt_pk_bf16(v1[2], v1[3]);
                *(u32x4*)(rowp + bj * HALF) = w; } }
    }
};

template <class Epi, class Sched, bool ALIGN_EPI>
__device__ __forceinline__ void gemm_phase(PG8_LAS unsigned char* lds, const Prob g, const Sched S, const Epi E, const int tid_in) {
    const int tid = tid_in, wid = __builtin_amdgcn_readfirstlane(tid >> 6), lane = tid & 63, wr = wid >> 2, wc = wid & 3, fr = lane & 15, fq = lane >> 4;
    int K = g.K; asm volatile("" : "+s"(K)); const int nt = K / BK;
    unsigned voffA[2], voffB[2];
#pragma unroll
    for (int i = 0; i < 2; ++i) { int R, C; stage_rc(tid * 16 + i * 8192, R, C); const int Rb = (R & ~31) + perm32(R & 31);
        voffA[i] = (unsigned)R * g.lda + (unsigned)C * 2u; voffB[i] = (unsigned)Rb * g.ldb + (unsigned)C * 2u; }
    const size_t kstep = (size_t)(BK * 2);
    const size_t hstepA = (size_t)HALF * g.lda, hstepB = (size_t)g.hsB;
    const size_t tstepA = 2 * hstepA;
    const unsigned ldsw = (unsigned)wid * 1024u;
    const int aoff = lds_byte(wr * 64 + fr, fq * 8), boff = lds_byte(wc * 32 + fr, fq * 8);
#define PG8_SA(b, h) (((b) * 2 + (h)) * HTB)
#define PG8_SB(b, h) ((4 + (b) * 2 + (h)) * HTB)
#define PG8_STAGE(bufoff, gbase, voff) do { _Pragma("unroll") for (int _i = 0; _i < 2; ++_i) \
        __builtin_amdgcn_global_load_lds((const unsigned*)((const char*)(gbase) + (voff)[_i]), (PG8_LAS unsigned*)(lds + (bufoff) + ldsw + _i * 8192), 16, 0, 0); } while (0)
#define PG8_LDA(dst, b, h) do { _Pragma("unroll") for (int m = 0; m < 4; ++m) _Pragma("unroll") for (int k = 0; k < 2; ++k) dst[m][k] = *(const PG8_LAS bf16x8*)(lds + PG8_SA(b, h) + aoff + m * 2048 + k * 1024); } while (0)
#define PG8_LDB(dst, b, h) do { _Pragma("unroll") for (int n = 0; n < 2; ++n) _Pragma("unroll") for (int k = 0; k < 2; ++k) dst[n][k] = *(const PG8_LAS bf16x8*)(lds + PG8_SB(b, h) + boff + n * 2048 + k * 1024); } while (0)
#define PG8_MMA(ai, bj, At, Bt) do { __builtin_amdgcn_s_setprio(1); _Pragma("unroll") for (int m = 0; m < 4; ++m) _Pragma("unroll") for (int n = 0; n < 2; ++n) _Pragma("unroll") for (int k = 0; k < 2; ++k) \
        acc[ai][bj][m][n] = __builtin_amdgcn_mfma_f32_16x16x32_bf16(Bt[n][k], At[m][k], acc[ai][bj][m][n], 0, 0, 0); __builtin_amdgcn_s_setprio(0); } while (0)
#define PG8_WAIT_V(n) asm volatile("s_waitcnt vmcnt(" #n ")" ::: "memory")
#define PG8_WAIT_L(n) asm volatile("s_waitcnt lgkmcnt(" #n ")" ::: "memory")
#define PG8_BAR __builtin_amdgcn_s_barrier()
#define PG8_SCHED __builtin_amdgcn_sched_barrier(0)
    Unit cur, nxt; int ui = 0;
    if (!S.next(0, cur)) return;
    f32x4 acc[2][2][4][2]; typename Epi::State est;
    E.init(acc, est, cur, wr, wc, fr, fq);
    bf16x8 At[4][2], B0[2][2], B1[2][2];
    const char* cA = g.A + (size_t)cur.pz * g.sAz + (size_t)cur.pm * tstepA; const char* cB = g.bbase(cur);
    PG8_STAGE(PG8_SB(0, 0), cB, voffB); PG8_STAGE(PG8_SB(0, 1), cB + hstepB, voffB); PG8_STAGE(PG8_SA(0, 0), cA, voffA); PG8_STAGE(PG8_SA(0, 1), cA + hstepA, voffA);
    if (wr == 1) PG8_BAR;
    PG8_WAIT_V(2); PG8_BAR;
    PG8_STAGE(PG8_SB(1, 0), cB + kstep, voffB); PG8_STAGE(PG8_SA(1, 0), cA + kstep, voffA); PG8_STAGE(PG8_SB(1, 1), cB + hstepB + kstep, voffB);
    PG8_WAIT_V(6); PG8_BAR;
    for (;;) {
        const bool has_next = S.next(ui + 1, nxt);
        const char* nA = has_next ? g.A + (size_t)nxt.pz * g.sAz + (size_t)nxt.pm * tstepA : cA; const char* nB = has_next ? g.bbase(nxt) : cB;
        for (int t = 0; t < nt; t += 2) {
            const bool last = (t == nt - 2);
            const char* a1 = cA + (size_t)(t + 1) * kstep;
            const char* a2 = last ? nA : cA + (size_t)(t + 2) * kstep; const char* b2 = last ? nB : cB + (size_t)(t + 2) * kstep;
            const char* a3 = a2 + kstep; const char* b3 = b2 + kstep;
            PG8_LDB(B0, 0, 0); PG8_LDB(B1, 0, 1); PG8_SCHED; PG8_LDA(At, 0, 0); PG8_STAGE(PG8_SA(1, 1), a1 + hstepA, voffA);
            PG8_WAIT_V(8); PG8_WAIT_L(0); PG8_BAR; PG8_MMA(0, 0, At, B0); PG8_MMA(0, 1, At, B1); PG8_BAR; PG8_SCHED;
            PG8_LDA(At, 0, 1); PG8_STAGE(PG8_SB(0, 0), b2, voffB); PG8_STAGE(PG8_SB(0, 1), b2 + hstepB, voffB); PG8_STAGE(PG8_SA(0, 0), a2, voffA);
            PG8_WAIT_V(8); PG8_WAIT_L(0); PG8_BAR; PG8_MMA(1, 0, At, B0); PG8_MMA(1, 1, At, B1); PG8_BAR; PG8_SCHED;
            PG8_LDB(B0, 1, 0); PG8_LDB(B1, 1, 1); PG8_SCHED; PG8_LDA(At, 1, 0); PG8_STAGE(PG8_SA(0, 1), a2 + hstepA, voffA);
            PG8_WAIT_V(8); PG8_WAIT_L(0); PG8_BAR; PG8_MMA(0, 0, At, B0); PG8_MMA(0, 1, At, B1); PG8_BAR; PG8_SCHED;
            PG8_LDA(At, 1, 1); PG8_STAGE(PG8_SB(1, 0), b3, voffB); PG8_STAGE(PG8_SB(1, 1), b3 + hstepB, voffB); PG8_STAGE(PG8_SA(1, 0), a3, voffA);
            PG8_WAIT_V(8); PG8_WAIT_L(0); PG8_BAR; PG8_MMA(1, 0, At, B0); PG8_MMA(1, 1, At, B1); PG8_BAR; PG8_SCHED;
        }
        if constexpr (ALIGN_EPI) { if (wr == 0) PG8_BAR; }
        E(acc, est, cur, wr, wc, fr, fq);
        if (!has_next) break;
        E.init(acc, est, nxt, wr, wc, fr, fq);
        cur = nxt; cA = nA; cB = nB; ++ui;
        if constexpr (ALIGN_EPI) { if (wr == 1) PG8_BAR; }
    }
    PG8_WAIT_V(0);
    if constexpr (!ALIGN_EPI) { if (wr == 0) PG8_BAR; }
    PG8_BAR;
#undef PG8_SA
#undef PG8_SB
#undef PG8_STAGE
#undef PG8_LDA
#undef PG8_LDB
#undef PG8_MMA
#undef PG8_WAIT_V
#undef PG8_WAIT_L
#undef PG8_BAR
#undef PG8_SCHED
}
}

namespace att {
typedef unsigned short bf16_t;
using bf16x8 = __attribute__((ext_vector_type(8))) short;
using s16x4  = __attribute__((ext_vector_type(4))) short;
using f32x16 = __attribute__((ext_vector_type(16))) float;
using u32x4  = __attribute__((ext_vector_type(4))) unsigned;
constexpr int NW = 8, QBLK = 32, KVBLK = 64;
constexpr int LDQ = 128, LDK = 128, LDV = 128, LDO = 1024;
#define KSWZ(row, colB) ((row) * 256 + ((colB) ^ (((row) & 7) << 4)))
#define SBAR() __builtin_amdgcn_sched_barrier(0)
template <int X> __device__ __forceinline__ float sx(float v) { return __int_as_float(__builtin_amdgcn_ds_swizzle(__float_as_int(v), 0x1f | (X << 10))); }
__device__ __forceinline__ int crow(int r, int hi) { return (r & 3) + 8 * (r >> 2) + 4 * hi; }
__device__ __forceinline__ unsigned cvtpk(float lo, float hi) { return pg8::cvt_pk_bf16(lo, hi); }
__device__ __forceinline__ int v_st(int k, int c) { const int kk = (k & ~0xC) | ((k & 4) << 1) | ((k & 8) >> 1); return ((kk >> 3) * 4 + (c >> 5)) * 512 + ((kk & 7) * 32 + (c & 31)) * 2; }
__device__ __forceinline__ int v_rd_base(int lane) { return ((lane & 3) << 3) | (((lane >> 2) & 3) << 6) | (((lane >> 4) & 1) << 5) | (((lane >> 5) & 1) << 8); }
constexpr int v_rd_off(int d0, int ks, int half) { return d0 * 512 + ks * 4096 + half * 2048; }
template <int OFF> __device__ __forceinline__ s16x4 tr_read(int vb) {
  s16x4 r; asm volatile("ds_read_b64_tr_b16 %0, %1 offset:%2" : "=&v"(r) : "v"(vb), "i"(OFF) : "memory"); return r;
}
typedef __attribute__((address_space(3))) char* lptr;
typedef short v4i16_t __attribute__((ext_vector_type(4)));
#define LDSV(T, p) (*(__attribute__((address_space(3))) T*)(p))
constexpr int KSLOT = 16640, VSLOT = 16384, NSLOT = 4, K_OFF = 0, V_OFF = NSLOT * KSLOT, WS_OFF = V_OFF + NSLOT * VSLOT;
constexpr int CH = 2080;
__device__ __forceinline__ int k_img(int key, int chunk, int h) { return chunk * CH + key * 32 + ((h ^ ((key >> 3) & 1)) * 16); }
template <int OFF> __device__ __forceinline__ bf16x8 rd128(int a) { bf16x8 r; asm volatile("ds_read_b128 %0, %1 offset:%2" : "=&v"(r) : "v"(a), "i"(OFF) : "memory"); return r; }
#define LWAIT(N) do { asm volatile("s_waitcnt lgkmcnt(" #N ")" ::: "memory"); SBAR(); } while (0)
__device__ __forceinline__ s16x4 vtr(lptr p) { return __builtin_bit_cast(s16x4, __builtin_amdgcn_ds_read_tr16_b64_v4i16((__attribute__((address_space(3))) v4i16_t*)p)); }
#define PK4(P, BASE, OUT) do { unsigned a0 = cvtpk(P[BASE + 0], P[BASE + 1]), a1 = cvtpk(P[BASE + 2], P[BASE + 3]);   \
    unsigned b0 = cvtpk(P[BASE + 4], P[BASE + 5]), b1 = cvtpk(P[BASE + 6], P[BASE + 7]);                              \
    auto r0 = __builtin_amdgcn_permlane32_swap(a0, b0, false, false); auto r1 = __builtin_amdgcn_permlane32_swap(a1, b1, false, false); \
    u32x4 w = {r0[0], r1[0], r0[1], r1[1]}; OUT = *reinterpret_cast<bf16x8*>(&w); } while (0)
template <bool SHIFT>
__device__ __forceinline__ void attn_unit(const bf16_t* __restrict__ Qb, const bf16_t* __restrict__ Kh, const bf16_t* __restrict__ Vh, bf16_t* __restrict__ Ob,
                                          int seq, float negshift, float lam, const float* __restrict__ gsub, float oscale, float eps, lptr lds, const int wave_in) {
  int lane_s; asm volatile("v_mbcnt_lo_u32_b32 %0, -1, 0\n\tv_mbcnt_hi_u32_b32 %0, -1, %0" : "=v"(lane_s));
  const int wid = wave_in, lane = lane_s, tid = wid * 64 + lane, r32 = lane & 31, hi = lane >> 5, comp = wid >> 2, wq = wid & 3;
#define UNI(x) __builtin_bit_cast(float, __builtin_amdgcn_readfirstlane(__builtin_bit_cast(int, (x))))
  lam = UNI(lam); oscale = UNI(oscale); eps = UNI(eps); negshift = UNI(negshift);
#undef UNI
  float l = 0.f; f32x16 o[4] = {}; bf16x8 qr[4];
  const bf16_t* Qw = Qb + (long)(wq * QBLK + r32) * LDQ + comp * 64 + hi * 8;
#pragma unroll
  for (int d0 = 0; d0 < 4; ++d0) qr[d0] = *reinterpret_cast<const bf16x8*>(Qw + d0 * 16);
  const int sr = tid >> 4, sc = (tid & 15) * 8;
  const lptr kwr = lds + K_OFF + k_img(sr, sc >> 4, (sc >> 3) & 1);
  const lptr vwr = lds + V_OFF + v_st(sr, sc);
  const lptr krd = lds + K_OFF + k_img(r32, comp * 4, hi);
  const lptr vrd = lds + V_OFF + v_rd_base(lane);
  unsigned voffK = (unsigned)(sr * LDK + sc) * 2u, voffV = (unsigned)(sr * LDV + sc) * 2u; asm volatile("" : "+v"(voffK), "+v"(voffV));
  const char* kg = (const char*)Kh; const char* vg = (const char*)Vh;
  bf16x8 vs0, vs1, ks0, ks1;
#define SLOAD() do { vs0 = *reinterpret_cast<const bf16x8*>(vg + voffV); vs1 = *reinterpret_cast<const bf16x8*>(vg + (size_t)32 * LDV * 2 + voffV); \
    ks0 = *reinterpret_cast<const bf16x8*>(kg + voffK); ks1 = *reinterpret_cast<const bf16x8*>(kg + (size_t)32 * LDK * 2 + voffK); kg += (size_t)KVBLK * LDK * 2; vg += (size_t)KVBLK * LDV * 2; } while (0)
#define SWRITE(sl) do { LDSV(bf16x8, vwr + (sl) * VSLOT) = vs0; LDSV(bf16x8, vwr + (sl) * VSLOT + 8192) = vs1; LDSV(bf16x8, kwr + (sl) * KSLOT) = ks0; LDSV(bf16x8, kwr + (sl) * KSLOT + 1024) = ks1; } while (0)
#define MSTEP(SC, SN, PP, PC, KO, VS, H, DO_QK, DO_PV) do { \
    bf16x8 kf[4]; s16x4 vl[4][2], vh[4][2]; \
    if (DO_QK) { _Pragma("unroll") for (int d0 = 0; d0 < 4; ++d0) kf[d0] = LDSV(const bf16x8, krd + (KO) + d0 * CH); } \
    if (DO_PV) { _Pragma("unroll") for (int d0 = 0; d0 < 4; ++d0) _Pragma("unroll") for (int ks = 0; ks < 2; ++ks) { \
        vl[d0][ks] = vtr(vrd + (VS) * VSLOT + v_rd_off(d0, 2 * (H) + ks, 0)); vh[d0][ks] = vtr(vrd + (VS) * VSLOT + v_rd_off(d0, 2 * (H) + ks, 1)); } } \
    if (DO_QK) { const f32x16 z = {}; SN = __builtin_amdgcn_mfma_f32_32x32x16_bf16(kf[0], qr[0], z, 0, 0, 0); \
        _Pragma("unroll") for (int d0 = 1; d0 < 4; ++d0) SN = __builtin_amdgcn_mfma_f32_32x32x16_bf16(kf[d0], qr[d0], SN, 0, 0, 0); } \
    { _Pragma("unroll") for (int r = 0; r < 16; ++r) SC[r] = __builtin_amdgcn_exp2f(SHIFT ? SC[r] + negshift : SC[r]); \
      float ps = 0.f; _Pragma("unroll") for (int r = 0; r < 16; ++r) ps += SC[r]; l += ps; \
      PK4(SC, 0, PC[0]); PK4(SC, 8, PC[1]); } \
    if (DO_PV) { _Pragma("unroll") for (int d0 = 0; d0 < 4; ++d0) _Pragma("unroll") for (int ks = 0; ks < 2; ++ks) { \
        const bf16x8 vf = (bf16x8){vl[d0][ks][0], vl[d0][ks][1], vl[d0][ks][2], vl[d0][ks][3], vh[d0][ks][0], vh[d0][ks][1], vh[d0][ks][2], vh[d0][ks][3]}; \
        o[d0] = __builtin_amdgcn_mfma_f32_32x32x16_bf16(PP[ks], vf, o[d0], 0, 0, 0); } } \
      \
    __builtin_amdgcn_sched_group_barrier(0x100, 20, 0); if (SHIFT) __builtin_amdgcn_sched_group_barrier(0x002, 16, 0); \
    _Pragma("unroll") for (int i_ = 0; i_ < 8; ++i_) { __builtin_amdgcn_sched_group_barrier(0x008, 1, 0); __builtin_amdgcn_sched_group_barrier(0x400, 2, 0); __builtin_amdgcn_sched_group_barrier(0x002, 2, 0); } \
    _Pragma("unroll") for (int i_ = 0; i_ < 4; ++i_) { __builtin_amdgcn_sched_group_barrier(0x008, 1, 0); __builtin_amdgcn_sched_group_barrier(0x002, 3, 0); } \
    SBAR(); } while (0)
#define STEP(TM, DO_PREV, DO_NEXT, DO_WR, DO_LD) do { \
    __syncthreads(); \
    MSTEP(sA, sB, pY, pX, (TM) * KSLOT + 1024, ((TM) + 3) & 3, 1, true, DO_PREV); \
    if (DO_WR) SWRITE(((TM) + 2) & 3); \
    if (DO_LD) SLOAD(); \
    MSTEP(sB, sA, pX, pY, (((TM) + 1) & 3) * KSLOT, TM, 0, DO_NEXT, true); } while (0)
  const int NT = seq / KVBLK;
  f32x16 sA, sB; bf16x8 pX[2], pY[2];
  if (comp == 0) __builtin_amdgcn_s_setprio(2);
  SLOAD(); SWRITE(0); SLOAD(); SWRITE(1); SLOAD();
  __syncthreads();
  { const f32x16 z = {}; sA = __builtin_amdgcn_mfma_f32_32x32x16_bf16(LDSV(const bf16x8, krd), qr[0], z, 0, 0, 0);
#pragma unroll
    for (int d0 = 1; d0 < 4; ++d0) sA = __builtin_amdgcn_mfma_f32_32x32x16_bf16(LDSV(const bf16x8, krd + d0 * CH), qr[d0], sA, 0, 0, 0); }
  STEP(0, false, true, true, true);
  STEP(1, true, true, true, true); STEP(2, true, true, true, true); STEP(3, true, true, true, true);
  for (int t = 4; t + 4 < NT; t += 4) {
    STEP(0, true, true, true, true); STEP(1, true, true, true, true); STEP(2, true, true, true, true); STEP(3, true, true, true, true);
  }
  STEP(0, true, true, true, true);
  STEP(1, true, true, true, false);
  STEP(2, true, true, false, false);
  STEP(3, true, false, false, false);
  { s16x4 vl[4][2], vh[4][2];
#pragma unroll
    for (int d0 = 0; d0 < 4; ++d0)
#pragma unroll
      for (int ks = 0; ks < 2; ++ks) { vl[d0][ks] = vtr(vrd + 3 * VSLOT + v_rd_off(d0, 2 + ks, 0)); vh[d0][ks] = vtr(vrd + 3 * VSLOT + v_rd_off(d0, 2 + ks, 1)); }
#pragma unroll
    for (int d0 = 0; d0 < 4; ++d0)
#pragma unroll
      for (int ks = 0; ks < 2; ++ks) { const bf16x8 vf = (bf16x8){vl[d0][ks][0], vl[d0][ks][1], vl[d0][ks][2], vl[d0][ks][3], vh[d0][ks][0], vh[d0][ks][1], vh[d0][ks][2], vh[d0][ks][3]};
        o[d0] = __builtin_amdgcn_mfma_f32_32x32x16_bf16(pY[ks], vf, o[d0], 0, 0, 0); } }
  __builtin_amdgcn_s_setprio(0);
#undef MSTEP
#undef SLOAD
#undef SWRITE
#undef STEP
  { auto rr = __builtin_amdgcn_permlane32_swap(__float_as_uint(l), __float_as_uint(l), false, false); l = __uint_as_float(rr[0]) + __uint_as_float(rr[1]); }
  int lane_e; asm volatile("v_mbcnt_lo_u32_b32 %0, -1, 0\n\tv_mbcnt_hi_u32_b32 %0, -1, %0" : "=v"(lane_e));
  const int r32e = lane_e & 31, hie = lane_e >> 5;
  __attribute__((address_space(3))) float* wse = (__attribute__((address_space(3))) float*)(lds + WS_OFF) + wid * 64;
  if (hie == 0) wse[r32e] = l;
  __syncthreads();
  lptr xb = lds + wq * (32 * 128 * 4) + (4 * hie * 128 + r32e) * 4;
  lptr wl = (lptr)wse + 4 * hie * 4;
  asm volatile("" : "+v"(xb), "+v"(wl));
#define CR(r) (((r) & 3) + 8 * ((r) >> 2))
  if (comp == 1) {
#pragma unroll
    for (int r = 0; r < 16; ++r) { const float c1 = lam * __builtin_amdgcn_rcpf(LDSV(float, wl + CR(r) * 4));
#pragma unroll
      for (int d0 = 0; d0 < 4; ++d0) LDSV(float, xb + CR(r) * 512 + d0 * 128) = o[d0][r] * c1; }
  }
  __syncthreads();
  if (comp == 0) {
    float gs[4];
#pragma unroll
    for (int d0 = 0; d0 < 4; ++d0) gs[d0] = gsub[d0 * 32 + r32e] * oscale;
    char* Ow = (char*)(Ob + (long)(wq * QBLK) * LDO);
    unsigned lofs = (unsigned)((4 * hie * LDO + r32e) * 2); asm volatile("" : "+v"(lofs));
#pragma unroll
    for (int r = 0; r < 16; ++r) {
      const float c0 = __builtin_amdgcn_rcpf(LDSV(float, wl + CR(r) * 4));
      float v[4]; float ss = 0.f;
#pragma unroll
      for (int d0 = 0; d0 < 4; ++d0) { v[d0] = o[d0][r] * c0 - LDSV(float, xb + CR(r) * 512 + d0 * 128); ss += v[d0] * v[d0]; }
      ss += sx<1>(ss); ss += sx<2>(ss); ss += sx<4>(ss); ss += sx<8>(ss); ss += sx<16>(ss);
      const float rs = __builtin_amdgcn_rsqf(ss * (1.0f / 128.0f) + eps);
#pragma unroll
      for (int d0 = 0; d0 < 4; ++d0) { const unsigned w = cvtpk(v[d0] * rs * gs[d0], 0.f); *(__attribute__((address_space(1))) bf16_t*)(Ow + (size_t)(CR(r) * LDO * 2 + d0 * 64) + lofs) = (bf16_t)(w & 0xffffu); }
    }
  }
#undef CR
  __syncthreads();
}
#undef LDSV
#undef KSWZ
#undef SBAR
}

constexpr int NWAVES = 8;
constexpr int BATCH = 2, SEQ = 8192, DM = 2048, DEPTH = 4, M = BATCH * SEQ;
constexpr int DFF = 5632, DIN = 8192, DFOUR = 1024, NHEAD = 8, QKD = 64, VD = 128;
constexpr float EPS = 1e-6f;
constexpr int ZC_UF = 0, ZC_Q = 1024, ZC_K = 2048, ZC_V = 3072, ZC_GF = 4096, ZC_GA = 6144;

constexpr size_t MiB = 1u << 20;
constexpr size_t WS_CTL = 0, CTL_ZERO_BYTES = 2 * MiB;
constexpr size_t WS_ROPE = 2 * MiB;
constexpr size_t WS_DFTC = 2 * MiB + 512 * 1024;
constexpr size_t WS_WBIG = WS_DFTC + 256 * 1024;
constexpr size_t WS_W2P  = WS_WBIG + 128 * 1024;
constexpr size_t WS_TW   = WS_W2P + 64 * 1024;
constexpr size_t WS_W = 3 * MiB, W_LAYER = 180 * MiB;
constexpr size_t WL_GUA = 0, WL_DA = 44 * MiB, WL_IN = 66 * MiB, WL_PF = 98 * MiB, WL_PA = 102 * MiB, WL_WO = 106 * MiB, WL_GUB = 114 * MiB, WL_DB = 158 * MiB;
constexpr size_t WS_H = WS_W + 4 * W_LAYER;
constexpr size_t WS_Z = WS_H + 64 * MiB;
constexpr size_t WS_QN = WS_Z + 256 * MiB, WS_KN = WS_QN + 32 * MiB;
constexpr size_t WS_ZT = WS_KN + 32 * MiB;
constexpr size_t WS_Y2 = WS_ZT + 64 * MiB;
constexpr size_t WS_F = WS_Y2 + 64 * MiB, WS_O = WS_F + 32 * MiB, WS_VN = WS_O + 32 * MiB, WS_END = WS_VN + 32 * MiB;
static_assert(WS_TW + 64 * 1024 <= WS_W, "tables fit below the weights");
constexpr int CW_BAR = 4096;
constexpr size_t WS_SSACC = 64 * 1024;
constexpr size_t WS_SSFFA = WS_SSACC + 8 * 131072;
static_assert(WS_SSFFA + 4 * 131072 <= CTL_ZERO_BYTES, "statistics inside the control region");
constexpr float SS_FIX = 1048576.0f, SS_INV = 1.0f / (1048576.0f * 2048.0f);

constexpr int RING_OFF = 0, RING_BYTES = 131072;
constexpr int LDSCTL_OFF = RING_BYTES + 4096, MISC_OFF = LDSCTL_OFF + 320;
constexpr int LDS_BYTES = 147456;

#define GAS __attribute__((address_space(1)))
#define LAS __attribute__((address_space(3)))
typedef unsigned short bf16;
typedef unsigned v4u __attribute__((ext_vector_type(4)));
typedef float f32x4 __attribute__((ext_vector_type(4)));
typedef GAS unsigned gu32;
#define RLX_AGENT __ATOMIC_RELAXED, __HIP_MEMORY_SCOPE_AGENT
#define LDS_WAIT() asm volatile("s_waitcnt lgkmcnt(0)" ::: "memory")
__device__ __forceinline__ unsigned f2bf(float f) { unsigned u = __builtin_bit_cast(unsigned, f); return (u + 0x7fffu + ((u >> 16) & 1u)) >> 16; }
__device__ __forceinline__ unsigned pk2(float lo, float hi) { return f2bf(lo) | (f2bf(hi) << 16); }

#define XB_TMO      128
#define XB_XCNT(j)  (256  + 64 * (j))
#define XB_XSUB(j)  (1280 + 64 * (j))
#define XB_XGEN(j)  (2304 + 64 * (j))
#define XB_TOP      3328
#define XB_TOPGEN   3392
#define XCD_BAR_WORDS 3456
#define XB_SPIN_CAP (1u << 18)
__device__ __forceinline__ unsigned xb_ld(unsigned* p)              { return __hip_atomic_load(p, __ATOMIC_RELAXED, __HIP_MEMORY_SCOPE_AGENT); }
__device__ __forceinline__ unsigned xb_add(unsigned* p, unsigned v) { return __hip_atomic_fetch_add(p, v, __ATOMIC_RELAXED, __HIP_MEMORY_SCOPE_AGENT); }
__device__ __forceinline__ unsigned xb_xcc_id() { return (unsigned)__builtin_amdgcn_s_getreg((3 << 11) | 20) & 0xFu; }
#define XB_SPIN(cond, bar) do { unsigned _sp = 0; while (cond) { __builtin_amdgcn_s_sleep(1); \
    if ((++_sp & 255u) == 0u) { if (xb_ld(&(bar)[XB_TMO])) break; if (_sp > XB_SPIN_CAP) { atomicAdd(&(bar)[XB_TMO], 1u); break; } } } } while (0)
struct XcdBarrier { unsigned* bar; unsigned x; volatile LAS unsigned* st; };
__device__ __forceinline__ XcdBarrier xcd_barrier_post(unsigned* bar, volatile LAS unsigned* st) {
    XcdBarrier b; b.bar = bar; b.x = xb_xcc_id(); b.st = st;
    if (threadIdx.x == 0) (void)xb_add(&bar[XB_XCNT(b.x)], 1u);
    return b;
}
__device__ __forceinline__ void xcd_barrier_complete(unsigned* bar, unsigned x, unsigned& nloc, unsigned& nx) {
    const unsigned G = gridDim.x * gridDim.y * gridDim.z;
    unsigned sum, cnt, mine, sp = 0u;
    for (;;) {
        sum = 0u; cnt = 0u; mine = 0u;
#pragma unroll
        for (unsigned j = 0; j < 16; ++j) { const unsigned c = xb_ld(&bar[XB_XCNT(j)]); sum += c; cnt += (c > 0u) ? 1u : 0u; mine = (j == x) ? c : mine; }
        if (sum == G) break;
        __builtin_amdgcn_s_sleep(1);
        if ((++sp & 255u) == 0u) { if (xb_ld(&bar[XB_TMO])) break; if (sp > XB_SPIN_CAP) { atomicAdd(&bar[XB_TMO], 1u); break; } }
    }
    nloc = mine > 0u ? mine : 1u; nx = cnt > 0u ? cnt : 1u;
}
__device__ __forceinline__ void xcd_barrier(const XcdBarrier& b) {
    asm volatile("s_waitcnt vmcnt(0)" ::: "memory");
    __syncthreads();
    if (threadIdx.x == 0) {
        unsigned* bar = b.bar;
        __builtin_amdgcn_s_waitcnt(0);
        unsigned nloc = b.st[0], nx = b.st[1];
        if (nloc == 0u) { xcd_barrier_complete(bar, b.x, nloc, nx); b.st[0] = nloc; b.st[1] = nx; }
        const unsigned old = xb_add(&bar[XB_XSUB(b.x)], 1u);
        const unsigned gen = old / nloc;
        if (old + 1u == (gen + 1u) * nloc) {
            __builtin_amdgcn_fence(__ATOMIC_RELEASE, "agent");
            asm volatile("s_waitcnt vmcnt(0)" ::: "memory");
            const unsigned og = xb_add(&bar[XB_TOP], 1u);
            const unsigned tg = og / nx;
            if (og + 1u == (tg + 1u) * nx) xb_add(&bar[XB_TOPGEN], 1u);
            else XB_SPIN(xb_ld(&bar[XB_TOPGEN]) == tg, bar);
            __builtin_amdgcn_fence(__ATOMIC_ACQUIRE, "agent");
            xb_add(&bar[XB_XGEN(b.x)], 1u);
            asm volatile("s_waitcnt vmcnt(0)" ::: "memory");
        } else {
            XB_SPIN(xb_ld(&bar[XB_XGEN(b.x)]) == gen, bar);
            __builtin_amdgcn_fence(__ATOMIC_ACQUIRE, "agent");
            asm volatile("s_waitcnt vmcnt(0)" ::: "memory");
        }
    }
    __syncthreads();
}

template <int X> __device__ __forceinline__ float swz_xor(float v) { return __int_as_float(__builtin_amdgcn_ds_swizzle(__float_as_int(v), 0x1f | (X << 10))); }
__device__ __forceinline__ float half_swap(float v) { auto rr = __builtin_amdgcn_permlane32_swap(__float_as_uint(v), __float_as_uint(v), false, false); return __uint_as_float(rr[0]) + __uint_as_float(rr[1]) - v; }
__device__ __forceinline__ float wave_sum(float v) {
    v += swz_xor<1>(v); v += swz_xor<2>(v); v += swz_xor<4>(v); v += swz_xor<8>(v); v += swz_xor<16>(v);
    { auto rr = __builtin_amdgcn_permlane32_swap(__float_as_uint(v), __float_as_uint(v), false, false); v = __uint_as_float(rr[0]) + __uint_as_float(rr[1]); }
    return v;
}
__device__ __forceinline__ float wave_max(float v) {
    v = fmaxf(v, swz_xor<1>(v)); v = fmaxf(v, swz_xor<2>(v)); v = fmaxf(v, swz_xor<4>(v)); v = fmaxf(v, swz_xor<8>(v)); v = fmaxf(v, swz_xor<16>(v));
    { auto rr = __builtin_amdgcn_permlane32_swap(__float_as_uint(v), __float_as_uint(v), false, false); v = fmaxf(__uint_as_float(rr[0]), __uint_as_float(rr[1])); }
    return v;
}
__device__ __forceinline__ void transpose_item(const float* W, int K, int N, bf16* WT, int map, LAS float* scr, int item, int lane, const float* gk = nullptr) {
    const int nblk = N / 32, kb = item / nblk, nb = item % nblk, k0 = 64 * kb, n0 = 32 * nb;
    const int r0 = (map == 0 || map == 3) ? n0 : (256 * (n0 >> 7) + (n0 & 127) + (map == 2 ? 128 : 0));
    const bool qkperm = (map == 3) && n0 >= 1024 && n0 < 3072;
#pragma unroll 8
    for (int i = 0; i < 32; ++i) { const int kk = 2 * i + (lane >> 5); scr[kk * 33 + (lane & 31)] = W[(size_t)(k0 + kk) * N + n0 + (lane & 31)]; }
    LDS_WAIT(); asm volatile("" ::: "memory");
    const int c = lane & 7;
    f32x4 ga = (f32x4){1.f, 1.f, 1.f, 1.f}, gb = ga;
    if (gk) { ga = *(const GAS f32x4*)(gk + k0 + 8 * c); gb = *(const GAS f32x4*)(gk + k0 + 8 * c + 4); }
#pragma unroll
    for (int j = 0; j < 4; ++j) { const int n = (lane >> 3) + 8 * j; const LAS float* s = scr + (8 * c) * 33 + n;
        v4u o; o.x = pk2(s[0 * 33] * ga.x, s[1 * 33] * ga.y); o.y = pk2(s[2 * 33] * ga.z, s[3 * 33] * ga.w); o.z = pk2(s[4 * 33] * gb.x, s[5 * 33] * gb.y); o.w = pk2(s[6 * 33] * gb.z, s[7 * 33] * gb.w);
        int rr = r0 + n;
        if (qkperm) { const int cc = n0 + n - 1024, hc = cc >> 6, d = cc & 63; rr = 1024 + 256 * (hc >> 2) + 128 * ((d >> 3) & 1) + 32 * (hc & 3) + 8 * (d >> 4) + 4 * ((d >> 2) & 1) + (d & 3); }
        *(GAS v4u*)(WT + (size_t)rr * K + k0 + 8 * c) = o; }
    LDS_WAIT(); asm volatile("" ::: "memory");
}
__device__ __forceinline__ void rms_row_to_bf16(const float* xrow, const f32x4 (&g)[8], bf16* orow, int lane) {
    const GAS f32x4* xr = (const GAS f32x4*)xrow + lane;
    f32x4 v[8]; float s = 0.f;
#pragma unroll
    for (int j = 0; j < 8; ++j) { v[j] = xr[64 * j]; s += (v[j].x * v[j].x + v[j].y * v[j].y) + (v[j].z * v[j].z + v[j].w * v[j].w); }
    const float rstd = 1.f / sqrtf(wave_sum(s) * (1.f / DM) + EPS);
    GAS unsigned long long* o8 = (GAS unsigned long long*)orow + lane;
#pragma unroll
    for (int j = 0; j < 8; ++j) { const f32x4 y = v[j] * rstd * g[j]; o8[64 * j] = (unsigned long long)pk2(y.x, y.y) | ((unsigned long long)pk2(y.z, y.w) << 32); }
}

__device__ __forceinline__ float row_to_bf16_ss(const float* xrow, bf16* orow, int lane) {
    const GAS f32x4* xr = (const GAS f32x4*)xrow + lane;
    GAS unsigned long long* o8 = (GAS unsigned long long*)orow + lane;
    float s = 0.f;
#pragma unroll
    for (int j = 0; j < 8; ++j) { const f32x4 v = xr[64 * j]; s += (v.x * v.x + v.y * v.y) + (v.z * v.z + v.w * v.w); o8[64 * j] = (unsigned long long)pk2(v.x, v.y) | ((unsigned long long)pk2(v.z, v.w) << 32); }
    return wave_sum(s);
}

struct Args { const float* in[22]; float* out; unsigned char* ws; int ph_lo, ph_hi; };


struct EpiWin {
    struct State { float rs[8]; };
    const Args* ka; const unsigned long long* ss; const float* gq; const float* gk;
    __device__ __forceinline__ void init(pg8::f32x4 (&acc)[2][2][4][2], State& st, const pg8::Unit& u, int wr, int, int fr, int) const {
        using pg8::f32x4; using pg8::BM; using pg8::HALF;
#pragma unroll
        for (int ai = 0; ai < 2; ++ai)
#pragma unroll
            for (int m = 0; m < 4; ++m) st.rs[ai * 4 + m] = __builtin_amdgcn_rsqf((float)ss[u.pm * BM + ai * HALF + wr * 64 + m * 16 + fr] * (1.0f / (1048576.0f * 2048.0f)) + 1e-6f);
#pragma unroll
        for (int a = 0; a < 2; ++a)
#pragma unroll
            for (int b = 0; b < 2; ++b)
#pragma unroll
                for (int m = 0; m < 4; ++m)
#pragma unroll
                    for (int n = 0; n < 2; ++n) acc[a][b][m][n] = (f32x4){0.f, 0.f, 0.f, 0.f};
    }
    __device__ __forceinline__ void operator()(const pg8::f32x4 (&acc)[2][2][4][2], const State& st, const pg8::Unit& u, int wr, int wc, int fr, int fq) const {
        using pg8::f32x4; using pg8::u32x4; using pg8::BM; using pg8::HALF; using pg8::cvt_pk_bf16;
        GAS unsigned char* wsb = (GAS unsigned char*)ka->ws;
        if (u.pn < 4 || u.pn >= 16) {
            GAS bf16* Z = (GAS bf16*)(wsb + WS_Z); const int col0 = u.pn * BM + wc * 32 + 8 * fq;
#pragma unroll
            for (int ai = 0; ai < 2; ++ai)
#pragma unroll
                for (int m = 0; m < 4; ++m) { const int row = u.pm * BM + ai * HALF + wr * 64 + m * 16 + fr; const float rs = st.rs[ai * 4 + m];
#pragma unroll
                    for (int bj = 0; bj < 2; ++bj) { const f32x4 v0 = acc[ai][bj][m][0] * rs, v1 = acc[ai][bj][m][1] * rs;
                        u32x4 w; w.x = cvt_pk_bf16(v0[0], v0[1]); w.y = cvt_pk_bf16(v0[2], v0[3]); w.z = cvt_pk_bf16(v1[0], v1[1]); w.w = cvt_pk_bf16(v1[2], v1[3]);
                        *(GAS u32x4*)(Z + (size_t)row * DIN + col0 + bj * HALF) = w; } }
        } else if (u.pn >= 12) {
            GAS bf16* V = (GAS bf16*)(wsb + WS_VN);
#pragma unroll
            for (int ai = 0; ai < 2; ++ai)
#pragma unroll
                for (int m = 0; m < 4; ++m) { const int row = u.pm * BM + ai * HALF + wr * 64 + m * 16 + fr; const float rs = st.rs[ai * 4 + m]; const int b = row >> 13, sq = row & 8191;
#pragma unroll
                    for (int bj = 0; bj < 2; ++bj) { const f32x4 v0 = acc[ai][bj][m][0] * rs, v1 = acc[ai][bj][m][1] * rs;
                        u32x4 w; w.x = cvt_pk_bf16(v0[0], v0[1]); w.y = cvt_pk_bf16(v0[2], v0[3]); w.z = cvt_pk_bf16(v1[0], v1[1]); w.w = cvt_pk_bf16(v1[2], v1[3]);
                        *(GAS u32x4*)(V + ((size_t)((b * NHEAD + 2 * (u.pn - 12) + bj) * SEQ + sq) * 128) + wc * 32 + 8 * fq) = w; } }
        } else {
            const int hca = 4 * (u.pn - 4) + wc, isk = hca >> 4, hc = hca & 15, hh = hc >> 1, cmp = hc & 1;
            GAS bf16* D = (GAS bf16*)(wsb + (isk ? WS_KN : WS_QN)); const GAS float* gg = (const GAS float*)(isk ? gk : gq) + 16 * fq;
            const GAS float* rope = (const GAS float*)(wsb + WS_ROPE);
            f32x4 g4[2][2];
#pragma unroll
            for (int bj = 0; bj < 2; ++bj)
#pragma unroll
                for (int n = 0; n < 2; ++n) g4[bj][n] = *(const GAS f32x4*)(gg + 8 * bj + 4 * n);
            const float qs = isk ? 1.0f : 0.125f * 1.4426950408889634f;
#pragma unroll
            for (int ai = 0; ai < 2; ++ai)
#pragma unroll
                for (int m = 0; m < 4; ++m) { const int row = u.pm * BM + ai * HALF + wr * 64 + m * 16 + fr; const float rs = st.rs[ai * 4 + m]; const int b = row >> 13, sq = row & 8191;
                    f32x4 x[2][2]; float q2 = 0.f;
#pragma unroll
                    for (int bj = 0; bj < 2; ++bj)
#pragma unroll
                        for (int n = 0; n < 2; ++n) { x[bj][n] = acc[ai][bj][m][n] * rs; q2 += (x[bj][n][0] * x[bj][n][0] + x[bj][n][1] * x[bj][n][1]) + (x[bj][n][2] * x[bj][n][2] + x[bj][n][3] * x[bj][n][3]); }
                    q2 += __int_as_float(__builtin_amdgcn_ds_swizzle(__float_as_int(q2), 0x1f | (16 << 10)));
                    { auto rr = __builtin_amdgcn_permlane32_swap(__float_as_uint(q2), __float_as_uint(q2), false, false); q2 = __uint_as_float(rr[0]) + __uint_as_float(rr[1]); }
                    const float rh = __builtin_amdgcn_rsqf(q2 * (1.0f / 64.0f) + 1e-6f);
#pragma unroll
                    for (int bj = 0; bj < 2; ++bj)
#pragma unroll
                        for (int n = 0; n < 2; ++n) x[bj][n] = x[bj][n] * rh * g4[bj][n];
                    if (fq == 0) {
                        const f32x4 c0 = *(const GAS f32x4*)(rope + sq * 16), c1 = *(const GAS f32x4*)(rope + sq * 16 + 4), s0 = *(const GAS f32x4*)(rope + sq * 16 + 8), s1 = *(const GAS f32x4*)(rope + sq * 16 + 12);
                        const f32x4 a0 = x[0][0], a1 = x[0][1], b0 = x[1][0], b1 = x[1][1];
                        x[0][0] = a0 * c0 - b0 * s0; x[0][1] = a1 * c1 - b1 * s1; x[1][0] = b0 * c0 + a0 * s0; x[1][1] = b1 * c1 + a1 * s1; }
                    GAS bf16* dp = D + ((size_t)((b * NHEAD + hh) * SEQ + sq) * 128) + cmp * 64 + 16 * fq;
#pragma unroll
                    for (int bj = 0; bj < 2; ++bj) { const f32x4 v0 = x[bj][0] * qs, v1 = x[bj][1] * qs;
                        u32x4 w; w.x = cvt_pk_bf16(v0[0], v0[1]); w.y = cvt_pk_bf16(v0[2], v0[3]); w.z = cvt_pk_bf16(v1[0], v1[1]); w.w = cvt_pk_bf16(v1[2], v1[3]);
                        *(GAS u32x4*)(dp + 8 * bj) = w; } }
        }
    }
};
template <int ALPHA2> struct EpiResid {
    struct State { };
    const Args* ka; int base_in; unsigned ss_off;
    __device__ __forceinline__ void init(pg8::f32x4 (&acc)[2][2][4][2], State&, const pg8::Unit& u, int wr, int wc, int fr, int fq) const {
        using pg8::f32x4; using pg8::BM; using pg8::HALF;
        const int col0 = u.pn * BM + wc * 32 + 8 * fq;
        if (base_in) {
            const GAS float* base = (const GAS float*)ka->in[0];
#pragma unroll
            for (int ai = 0; ai < 2; ++ai)
#pragma unroll
                for (int m = 0; m < 4; ++m) { const size_t off = (size_t)(u.pm * BM + ai * HALF + wr * 64 + m * 16 + fr) * DM + col0;
#pragma unroll
                    for (int bj = 0; bj < 2; ++bj)
#pragma unroll
                        for (int n = 0; n < 2; ++n) acc[ai][bj][m][n] = *(const GAS f32x4*)(base + off + bj * HALF + 4 * n) * (2.0f / ALPHA2); }
        } else {
            const GAS bf16* xb = (const GAS bf16*)((GAS unsigned char*)ka->ws + WS_H);
#pragma unroll
            for (int ai = 0; ai < 2; ++ai)
#pragma unroll
                for (int m = 0; m < 4; ++m) { const size_t off = (size_t)(u.pm * BM + ai * HALF + wr * 64 + m * 16 + fr) * DM + col0;
#pragma unroll
                    for (int bj = 0; bj < 2; ++bj) { const pg8::u32x4 w = *(const GAS pg8::u32x4*)(xb + off + bj * HALF);
                        acc[ai][bj][m][0] = (f32x4){pg8::bf_lo(w.x), pg8::bf_hi(w.x), pg8::bf_lo(w.y), pg8::bf_hi(w.y)} * (2.0f / ALPHA2);
                        acc[ai][bj][m][1] = (f32x4){pg8::bf_lo(w.z), pg8::bf_hi(w.z), pg8::bf_lo(w.w), pg8::bf_hi(w.w)} * (2.0f / ALPHA2); } }
        }
    }
    __device__ __forceinline__ void operator()(const pg8::f32x4 (&acc)[2][2][4][2], const State& st, const pg8::Unit& u, int wr, int wc, int fr, int fq) const {
        using pg8::f32x4; using pg8::u32x4; using pg8::BM; using pg8::HALF;
        GAS unsigned char* wsb = (GAS unsigned char*)ka->ws; GAS bf16* xb = (GAS bf16*)(wsb + WS_H); GAS unsigned long long* ssacc = (GAS unsigned long long*)(wsb + ss_off);
        const float alpha = 0.5f * ALPHA2;
        const int col0 = u.pn * BM + wc * 32 + 8 * fq;
#pragma unroll
        for (int ai = 0; ai < 2; ++ai)
#pragma unroll
            for (int m = 0; m < 4; ++m) { const int row = u.pm * BM + ai * HALF + wr * 64 + m * 16 + fr;
            const size_t off = (size_t)row * DM + col0;
            float q = 0.f;
#pragma unroll
            for (int bj = 0; bj < 2; ++bj) { f32x4 b[2];
#pragma unroll
                for (int n = 0; n < 2; ++n) { b[n] = acc[ai][bj][m][n] * alpha;
                    q += (b[n][0] * b[n][0] + b[n][1] * b[n][1]) + (b[n][2] * b[n][2] + b[n][3] * b[n][3]); }
                u32x4 w; w.x = pg8::cvt_pk_bf16(b[0][0], b[0][1]); w.y = pg8::cvt_pk_bf16(b[0][2], b[0][3]); w.z = pg8::cvt_pk_bf16(b[1][0], b[1][1]); w.w = pg8::cvt_pk_bf16(b[1][2], b[1][3]);
                *(GAS u32x4*)(xb + off + bj * HALF) = w; }
            q += __int_as_float(__builtin_amdgcn_ds_swizzle(__float_as_int(q), 0x1f | (16 << 10)));
            { auto rr = __builtin_amdgcn_permlane32_swap(__float_as_uint(q), __float_as_uint(q), false, false); q = __uint_as_float(rr[0]) + __uint_as_float(rr[1]); }
            if (fq == 0) __hip_atomic_fetch_add(ssacc + row, (unsigned long long)(q * SS_FIX + 0.5f), __ATOMIC_RELAXED, __HIP_MEMORY_SCOPE_AGENT);
        }
    }
};


__global__ void __launch_bounds__(NWAVES * 64, 2) enc_fwd(Args args) {
    extern __shared__ __attribute__((aligned(16))) unsigned char lds[];
    LAS unsigned char* const L = (LAS unsigned char*)lds;
    volatile LAS unsigned* MISC = (volatile LAS unsigned*)(L + MISC_OFF);
    const int wave0 = __builtin_amdgcn_readfirstlane(threadIdx.x >> 6);
#define LANE_SETUP() int G = gridDim.x, bx = blockIdx.x; asm volatile("" : "+s"(G), "+s"(bx)); const int vcu = (G % 8 == 0) ? (bx % 8) * (G / 8) + bx / 8 : bx; const int NGW = G * NWAVES; (void)NGW; int lane_; asm volatile("v_mbcnt_lo_u32_b32 %0, -1, 0\n\tv_mbcnt_hi_u32_b32 %0, -1, %0" : "=v"(lane_)); int wave = wave0; asm volatile("" : "+s"(wave)); const int lane = lane_, tid = wave * 64 + lane; (void)tid; const int gw = vcu * NWAVES + wave; (void)lane; (void)gw
    gu32* ctl = (gu32*)(args.ws + WS_CTL);
#define Hb ((bf16*)(GAS bf16*)(ws + WS_H))
#define SSACC(i) ((unsigned long long*)(GAS unsigned long long*)(ws + WS_SSACC) + (size_t)(i) * M)
#define SSFFA(i) ((unsigned long long*)(GAS unsigned long long*)(ws + WS_SSFFA) + (size_t)(i) * M)
#define Zb ((bf16*)(GAS bf16*)(ws + WS_Z))
#define HID ((bf16*)(GAS bf16*)(ws + WS_Z))
#define QN ((bf16*)(GAS bf16*)(ws + WS_QN))
#define KN ((bf16*)(GAS bf16*)(ws + WS_KN))
#define VN ((bf16*)(GAS bf16*)(ws + WS_VN))
#define ZT ((bf16*)(GAS bf16*)(ws + WS_ZT))
#define MB ((bf16*)(GAS bf16*)(ws + WS_ZT))
#define Fb ((bf16*)(GAS bf16*)(ws + WS_F))
#define Ob ((bf16*)(GAS bf16*)(ws + WS_O))
#define ROPE ((float*)(GAS float*)(ws + WS_ROPE))
#define DFTC ((bf16*)(GAS bf16*)(ws + WS_DFTC))
#define WBIG ((bf16*)(GAS bf16*)(ws + WS_WBIG))
#define W2P ((bf16*)(GAS bf16*)(ws + WS_W2P))
#define TWT ((float*)(GAS float*)(ws + WS_TW))
#define Y2b ((bf16*)(GAS bf16*)(ws + WS_Y2))
#define x_in (args.in[0])
#define xo   (args.out)
#define PH_SETUP() GAS unsigned char* ws = (GAS unsigned char*)args.ws; asm volatile("" : "+s"(ws)); int layer = hl >> 1; asm volatile("" : "+s"(layer)); GAS unsigned char* wl = ws + WS_W + (size_t)layer * W_LAYER; (void)wl; LANE_SETUP()
    for (int u = threadIdx.x; u < (LDS_BYTES - LDSCTL_OFF) / 4; u += NWAVES * 64) ((LAS unsigned*)(L + LDSCTL_OFF))[u] = 0u;
    __syncthreads();
    XcdBarrier bar; bar.bar = (unsigned*)(ctl + CW_BAR); bar.x = 0; bar.st = nullptr;
    if (MK_ONE_LAUNCH) bar = xcd_barrier_post((unsigned*)(ctl + CW_BAR), MISC + 8);
    const int lo = args.ph_lo, hi = args.ph_hi;
    int ph = 0;
#define IN_PH() (lo <= ph && ph < hi)
#define END_PH() do { if (MK_ONE_LAUNCH && lo <= ph && ph + 1 < hi) xcd_barrier(bar); ++ph; } while (0)

    if (IN_PH()) { {
        GAS unsigned char* ws = (GAS unsigned char*)args.ws; asm volatile("" : "+s"(ws)); LANE_SETUP();
        LAS float* scr = (LAS float*)(L + RING_OFF + wave * 16384);
        constexpr int I_G = (DM / 64) * (DFF / 32), I_D = (DFF / 64) * (DM / 32), I_IN = (DM / 64) * (DIN / 32), I_P = (DFOUR / 64) * (DM / 32), I_O = (DM / 64) * (DM / 32);
        constexpr int C1 = I_G, C2 = C1 + I_G, C3 = C2 + I_D, C4 = C3 + I_IN, C5 = C4 + I_P, C6 = C5 + I_P, C7 = C6 + I_O, C8 = C7 + I_G, C9 = C8 + I_G, C10 = C9 + I_D;
        for (int layer = 0; layer < DEPTH; ++layer) {
            GAS unsigned char* wl = ws + WS_W + (size_t)layer * W_LAYER;
            const float* gate_a = args.in[2] + (size_t)layer * DM * DFF; const float* up_a = args.in[3] + (size_t)layer * DM * DFF; const float* down_a = args.in[4] + (size_t)layer * DFF * DM;
            const float* w_in = args.in[6] + (size_t)layer * DM * DIN; const float* p_f = args.in[14] + (size_t)layer * DFOUR * DM; const float* p_a = args.in[15] + (size_t)layer * DFOUR * DM;
            const float* w_o = args.in[16] + (size_t)layer * DM * DM;
            const float* gate_b = args.in[18] + (size_t)layer * DM * DFF; const float* up_b = args.in[19] + (size_t)layer * DM * DFF; const float* down_b = args.in[20] + (size_t)layer * DFF * DM;
            for (int it = gw; it < C10; it += NGW) {
                if (it < C1)      transpose_item(gate_a, DM, DFF, (bf16*)(wl + WL_GUA), 1, scr, it, lane, args.in[1] + (size_t)layer * DM);
                else if (it < C2) transpose_item(up_a, DM, DFF, (bf16*)(wl + WL_GUA), 2, scr, it - C1, lane, args.in[1] + (size_t)layer * DM);
                else if (it < C3) transpose_item(down_a, DFF, DM, (bf16*)(wl + WL_DA), 0, scr, it - C2, lane);
                else if (it < C4) transpose_item(w_in, DM, DIN, (bf16*)(wl + WL_IN), 3, scr, it - C3, lane, args.in[5] + (size_t)layer * DM);
                else if (it < C5) transpose_item(p_f, DFOUR, DM, (bf16*)(wl + WL_PF), 0, scr, it - C4, lane);
                else if (it < C6) transpose_item(p_a, DFOUR, DM, (bf16*)(wl + WL_PA), 0, scr, it - C5, lane);
                else if (it < C7) transpose_item(w_o, DM, DM, (bf16*)(wl + WL_WO), 0, scr, it - C6, lane);
                else if (it < C8) transpose_item(gate_b, DM, DFF, (bf16*)(wl + WL_GUB), 1, scr, it - C7, lane, args.in[17] + (size_t)layer * DM);
                else if (it < C9) transpose_item(up_b, DM, DFF, (bf16*)(wl + WL_GUB), 2, scr, it - C8, lane, args.in[17] + (size_t)layer * DM);
                else              transpose_item(down_b, DFF, DM, (bf16*)(wl + WL_DB), 0, scr, it - C9, lane);
            }
        }
        const int gt = (vcu * NWAVES + wave) * 64 + lane, NGT = NGW * 64;
        for (int i = gt; i < 256 * 256; i += NGT) { const int r = i >> 8, c = i & 255, pr = r >> 7, s1p = r & 127, pc = c >> 7, s1 = c & 127, j = (s1 * s1p) & 127;
            float sn, cs; sincospif((float)j * (1.0f / 64.0f), &sn, &cs); WBIG[i] = (bf16)f2bf(pr == pc ? cs : (pr ? sn : -sn)); }
        for (int i = gt; i < 256 * 128; i += NGT) { const int r = i >> 7, c = i & 127, pc = c >> 6, s2 = c & 63, j = (s2 * r) & 63;
            float sn, cs; sincospif((float)j * (1.0f / 32.0f), &sn, &cs); W2P[i] = (bf16)f2bf(r < 64 ? (pc ? -sn : cs) : 0.0f); }
        for (int i = gt; i < 128 * 64; i += NGT) { const int s1p = i >> 6, s2 = i & 63; float sn, cs; sincospif((float)(s1p * s2) * (1.0f / 4096.0f), &sn, &cs); TWT[2 * i] = cs; TWT[2 * i + 1] = sn; }
        for (int i = gt; i < 512 * 256; i += NGT) { const int r = i >> 8, c = i & 255, part = r >> 8, cp = r & 255, j = (c * cp) & 255;
            float sn, cs; sincospif((float)j * (1.0f / 128.0f), &sn, &cs); DFTC[i] = (bf16)f2bf((part ? sn : cs) * 0.0625f); }
        for (int i = gt; i < SEQ * 8; i += NGT) { const int s = i >> 3, j = i & 7;
            const double inv = j == 0 ? 1.0 : j == 1 ? 0.19392274474868576 : j == 2 ? 0.03760603093086393 : j == 3 ? 0.007292664737217109 : j == 4 ? 0.001414213562373095 : j == 5 ? 0.0002742481756762073 : j == 6 ? 5.318295896944988e-05 : 1.031338537721246e-05;
            const double rev = (double)s * inv * 0.15915494309189535;
            const float fr = (float)(rev - __builtin_rint(rev)); float sn, cs; sincospif(2.0f * fr, &sn, &cs);
            ROPE[s * 16 + j] = cs; ROPE[s * 16 + 8 + j] = sn; }
        for (int m = gw; m < M; m += NGW) { const float ssq = row_to_bf16_ss(x_in + (size_t)m * DM, Hb + (size_t)m * DM, lane); if (lane == 0) SSFFA(0)[m] = (unsigned long long)(ssq * SS_FIX + 0.5f); }
    } }
    END_PH();

    for (int hl = 0; hl < 2 * DEPTH; ++hl) {
        const int ff = hl & 1;
        if (IN_PH()) { PH_SETUP();
            pg8::Prob g = pg8::mk_prob(Hb, (const char*)(wl + (ff ? WL_GUB : WL_GUA)), DM * 2, DM * 2, 0, 0, DM);
            pg8::GridOrder S; S.init(M / 256, 2 * DFF / 256, 1, G, bx);
            pg8::EpiSwiglu E{HID, DFF, ff ? SSACC(2 * layer + 1) : SSFFA(layer)};
            pg8::gemm_phase<pg8::EpiSwiglu, pg8::GridOrder, true>(L + RING_OFF, g, S, E, tid);
        }
        END_PH();
        if (IN_PH()) { PH_SETUP();
            pg8::Prob g = pg8::mk_prob(HID, (const char*)(wl + (ff ? WL_DB : WL_DA)), DFF * 2, DFF * 2, 0, 0, DFF);
            pg8::GridOrder S; S.init(M / 256, DM / 256, 1, G, bx, 4);
            if (ff == 0) {
                EpiResid<1> E{&args, hl == 0, (unsigned)(WS_SSACC + (size_t)(2 * layer) * M * 8)};
                pg8::gemm_phase<EpiResid<1>, pg8::GridOrder, true>(L + RING_OFF, g, S, E, tid);
            } else {
                pg8::EpiBf16 E{Y2b, DM, 1.0f, 0, nullptr};
                pg8::gemm_phase<pg8::EpiBf16, pg8::GridOrder, true>(L + RING_OFF, g, S, E, tid);
            }
        }
        END_PH();
        if (ff == 0) {
            if (IN_PH()) { PH_SETUP();
                pg8::Prob g = pg8::mk_prob(Hb, (const char*)(wl + WL_IN), DM * 2, DM * 2, 0, 0, DM);
                pg8::GridOrder S; S.init(M / 256, DIN / 256, 1, G, bx);
                EpiWin E{&args, SSACC(2 * layer), args.in[7] + (size_t)layer * QKD, args.in[8] + (size_t)layer * QKD};
                pg8::gemm_phase<EpiWin, pg8::GridOrder, true>(L + RING_OFF, g, S, E, tid);
            }
            END_PH();
            if (IN_PH()) { PH_SETUP();
                pg8::Prob g = pg8::mk_prob(DFTC, (Zb + ZC_UF), 256 * 2, 64 * DIN * 2, 0, 256 * 2, 256);
                g.hsB = DIN * 2; g.m0 = 31u; g.s0 = (size_t)2 * DIN * 2; g.sh1 = 5; g.m1 = 1u; g.s1 = (size_t)SEQ * DIN * 2; g.sh2 = 31; g.s2 = 0;
                pg8::GridOrder S; S.init(2, M / 256, 4, G, bx);
                pg8::EpiCstep E{ZT};
                pg8::gemm_phase<pg8::EpiCstep, pg8::GridOrder, true>(L + RING_OFF, g, S, E, tid);
            }
            END_PH();
            if (IN_PH()) { PH_SETUP();
                pg8::Prob g = pg8::mk_prob(WBIG, ZT, 256 * 2, 256 * 2, 0, 0, 256);
                pg8::GridOrder S; S.init(1, (1024 * 2 * 64) / 256, 1, G, bx);
                pg8::EpiS1 E{Y2b, TWT};
                pg8::gemm_phase<pg8::EpiS1, pg8::GridOrder, true>(L + RING_OFF, g, S, E, tid);
            }
            END_PH();
            if (IN_PH()) { PH_SETUP();
                float lam, negshift;
                { const float a = args.in[9][layer * QKD + lane] * args.in[10][layer * QKD + lane], b = args.in[11][layer * QKD + lane] * args.in[12][layer * QKD + lane];
                  const float lam_init = 0.8f - 0.6f * expf(-0.3f * (float)layer);
                  lam = expf(wave_sum(a)) - expf(wave_sum(b)) + lam_init; lam = __builtin_bit_cast(float, __builtin_amdgcn_readfirstlane(__builtin_bit_cast(int, lam)));
                  const float mq = wave_max(fabsf(args.in[7][layer * QKD + lane])), mk = wave_max(fabsf(args.in[8][layer * QKD + lane]));
                  const float bound = 8.0f * 1.4426950408889634f * mq * mk;
                  negshift = -fminf(bound, 60.0f); negshift = __builtin_bit_cast(float, __builtin_amdgcn_readfirstlane(__builtin_bit_cast(int, negshift))); }
                const bool noshift = negshift > -60.0f;
                const float lam_init = __builtin_bit_cast(float, __builtin_amdgcn_readfirstlane(__builtin_bit_cast(int, 0.8f - 0.6f * expf(-0.3f * (float)layer))));
                const float* gsub = args.in[13] + (size_t)layer * VD;
                for (int i = 0; i < 4; ++i) {
                    if (G != 256) break;
                    const int bh = (vcu >> 5) + 8 * (i >> 1), qb = (i & 1) * 32 + (vcu & 31), b = bh >> 3, h = bh & 7;
                    const size_t row0 = (size_t)b * SEQ, hb = (size_t)bh * SEQ * 128;
                    if (noshift) att::attn_unit<false>(QN + hb + (size_t)qb * 128 * 128, KN + hb, VN + hb, Ob + (row0 + qb * 128) * 1024 + h * 128,
                                   SEQ, negshift, lam, gsub, 1.0f - lam_init, EPS, (att::lptr)(L + RING_OFF), wave);
                    else         att::attn_unit<true>(QN + hb + (size_t)qb * 128 * 128, KN + hb, VN + hb, Ob + (row0 + qb * 128) * 1024 + h * 128,
                                   SEQ, negshift, lam, gsub, 1.0f - lam_init, EPS, (att::lptr)(L + RING_OFF), wave);
                }
                pg8::Prob g = pg8::mk_prob(W2P, Y2b, 128 * 2, 2 * 128 * 2, 0, 0, 128);
                g.m0 = 3u; g.s0 = (size_t)256 * 512; g.sh1 = 2; g.m1 = 127u; g.s1 = (size_t)1024 * 512; g.sh2 = 9; g.s2 = 256;
                pg8::GridOrder S; S.init(1, BATCH * 128 * 4, 1, G, bx);
                pg8::EpiS2 E{Fb, 0.011048543456039806f};
                int lane_b; asm volatile("v_mbcnt_lo_u32_b32 %0, -1, 0\n\tv_mbcnt_hi_u32_b32 %0, -1, %0" : "=v"(lane_b));
                pg8::gemm_phase<pg8::EpiS2, pg8::GridOrder, true>(L + RING_OFF, g, S, E, wave * 64 + lane_b);
            }
            END_PH();
            if (IN_PH()) { PH_SETUP();
                pg8::Prob g = pg8::mk_prob(Fb, (const char*)(wl + WL_PF), DFOUR * 2, DFOUR * 2, (size_t)(WS_O - WS_F), (size_t)(WL_PA - WL_PF), DFOUR);
                pg8::GridOrder S; S.init(M / 256, DM / 256, 1, G, bx, pg8::WGM, 2);
                pg8::EpiGate2 E{Zb + ZC_GF, Zb + ZC_GA, DIN, MB, DM};
                pg8::gemm_phase<pg8::EpiGate2, pg8::GridOrder, true>(L + RING_OFF, g, S, E, tid);
            }
            END_PH();
            if (IN_PH()) { PH_SETUP();
                pg8::Prob g = pg8::mk_prob(MB, (const char*)(wl + WL_WO), DM * 2, DM * 2, 0, 0, DM);
                pg8::GridOrder S; S.init(M / 256, DM / 256, 1, G, bx);
                EpiResid<2> E{&args, 0, (unsigned)(WS_SSACC + (size_t)(2 * layer + 1) * M * 8)};
                pg8::gemm_phase<EpiResid<2>, pg8::GridOrder, true>(L + RING_OFF, g, S, E, tid);
            }
            END_PH();
        } else {
            if (IN_PH()) { PH_SETUP();
                f32x4 go[8];
                const bool has_next = (layer + 1 < DEPTH);
#pragma unroll
                for (int j = 0; j < 8; ++j) go[j] = *((const GAS f32x4*)(args.in[21] + (size_t)layer * DM) + lane + 64 * j);
                for (int m = gw; m < M; m += NGW) {
                    GAS unsigned long long* xr = (GAS unsigned long long*)(Hb + (size_t)m * DM) + lane;
                    f32x4 v[8]; float s = 0.f;
#pragma unroll
                    for (int j = 0; j < 8; ++j) { const unsigned long long xw = xr[64 * j], yw = ((const GAS unsigned long long*)(Y2b + (size_t)m * DM) + lane)[64 * j];
                        v[j] = (f32x4){pg8::bf_lo((unsigned)xw), pg8::bf_hi((unsigned)xw), pg8::bf_lo((unsigned)(xw >> 32)), pg8::bf_hi((unsigned)(xw >> 32))}
                             + 0.5f * (f32x4){pg8::bf_lo((unsigned)yw), pg8::bf_hi((unsigned)yw), pg8::bf_lo((unsigned)(yw >> 32)), pg8::bf_hi((unsigned)(yw >> 32))};
                        s += (v[j].x * v[j].x + v[j].y * v[j].y) + (v[j].z * v[j].z + v[j].w * v[j].w); }
                    const float rstd = 1.f / sqrtf(wave_sum(s) * (1.f / DM) + EPS);
                    float s2 = 0.f;
#pragma unroll
                    for (int j = 0; j < 8; ++j) { v[j] = v[j] * rstd * go[j]; s2 += (v[j].x * v[j].x + v[j].y * v[j].y) + (v[j].z * v[j].z + v[j].w * v[j].w); }
                    if (has_next) {
                        const float ss2 = wave_sum(s2);
#pragma unroll
                        for (int j = 0; j < 8; ++j) xr[64 * j] = (unsigned long long)pk2(v[j].x, v[j].y) | ((unsigned long long)pk2(v[j].z, v[j].w) << 32);
                        if (lane == 0) SSFFA(layer + 1)[m] = (unsigned long long)(ss2 * SS_FIX + 0.5f);
                    } else {
                        GAS f32x4* orow = (GAS f32x4*)(xo + (size_t)m * DM) + lane;
#pragma unroll
                        for (int j = 0; j < 8; ++j) orow[64 * j] = v[j];
                    }
                }
            }
            END_PH();
        }
    }
#undef IN_PH
#undef END_PH
}

constexpr int N_PHASES = 1 + DEPTH * (2 + 6 + 2 + 1);

extern "C" void kernel_launch(void* const* d_in, const int* in_sizes, int n_in, void* d_out, int out_size, void* d_ws, size_t ws_size, hipStream_t stream) {
    static int grid = 0;
    if (grid == 0) {
        if (n_in != 22 || in_sizes[0] != M * DM || out_size != M * DM || ws_size < WS_END) {
            fprintf(stderr, "kernel_launch: shape/workspace mismatch: n_in %d in0 %d out %d ws %zu (need %zu); nothing launched\n", n_in, n_in > 0 ? in_sizes[0] : -1, out_size, ws_size, (size_t)WS_END); grid = -1; return; }
        int dev = 0, cus = 0;
        if (hipGetDevice(&dev) != hipSuccess || hipDeviceGetAttribute(&cus, hipDeviceAttributeMultiprocessorCount, dev) != hipSuccess) { fprintf(stderr, "kernel_launch: device query failed\n"); grid = -1; return; }
        if (hipFuncSetAttribute((const void*)enc_fwd, hipFuncAttributeMaxDynamicSharedMemorySize, LDS_BYTES) != hipSuccess) { fprintf(stderr, "kernel_launch: hipFuncSetAttribute failed\n"); grid = -1; return; }
        int per_cu = 0;
        if (hipOccupancyMaxActiveBlocksPerMultiprocessor(&per_cu, (const void*)enc_fwd, NWAVES * 64, LDS_BYTES) != hipSuccess || per_cu < 1)
            fprintf(stderr, "kernel_launch: note: occupancy query reports %d workgroups per CU\n", per_cu);
        (void)hipGetLastError();
        grid = cus;
        if (grid != 256) fprintf(stderr, "kernel_launch: %d CUs; the attention phase assumes 256\n", grid);
    }
    if (grid < 0) return;
    if (hipMemsetAsync((char*)d_ws + WS_CTL, 0, CTL_ZERO_BYTES, stream) != hipSuccess) { fprintf(stderr, "kernel_launch: memset failed\n"); return; }
    Args a{};
    for (int i = 0; i < 22; ++i) a.in[i] = (const float*)d_in[i];
    a.out = (float*)d_out; a.ws = (unsigned char*)d_ws;
#if MK_ONE_LAUNCH
    a.ph_lo = 0; a.ph_hi = N_PHASES;
    hipLaunchKernelGGL(enc_fwd, dim3(grid), dim3(NWAVES * 64), LDS_BYTES, stream, a);
#else
    for (int p = 0; p < N_PHASES; ++p) { a.ph_lo = p; a.ph_hi = p + 1; hipLaunchKernelGGL(enc_fwd, dim3(grid), dim3(NWAVES * 64), LDS_BYTES, stream, a); }
#endif
    const hipError_t le = hipPeekAtLastError();
    if (le != hipSuccess) fprintf(stderr, "kernel_launch: launch failed: %s\n", hipGetErrorName(le));
}
```

```cpp
#include <hip/hip_runtime.h>
#include <cstdio>
#include <cstdint>

#ifndef MK_ONE_LAUNCH
#define MK_ONE_LAUNCH 1
#endif

namespace pg8 {
#define PG8_LAS __attribute__((address_space(3)))
typedef unsigned short bf16_t;
typedef short bf16x8 __attribute__((ext_vector_type(8)));
typedef float f32x4 __attribute__((ext_vector_type(4)));
typedef float f32x2 __attribute__((ext_vector_type(2)));
typedef unsigned u32x4 __attribute__((ext_vector_type(4)));
constexpr int BM = 256, BK = 64, HALF = 128, HTB = HALF * BK * 2, STAGE_BYTES = 8 * HTB, NXCD = 8, WGM = 8;

__host__ __device__ __forceinline__ int lds_byte(int r, int c) { const int st = (r >> 4) * 2 + (c >> 5), rr = r & 15, cc = c & 31, ob = rr * 64 + cc * 2; return st * 1024 + (ob ^ (((ob >> 9) & 1) << 5)); }
__host__ __device__ __forceinline__ void stage_rc(int b, int& R, int& C) { const int st = b / 1024, sb = b % 1024, swz = sb ^ (((sb >> 9) & 1) << 5); R = (st >> 1) * 16 + swz / 64; C = (st & 1) * 32 + (swz % 64) / 2; }
__host__ __device__ __forceinline__ int perm32(int rho) { const int n = rho >> 4, i = rho & 15; return 8 * (i >> 2) + 4 * n + (i & 3); }

struct Unit { int pm, pn, pz; };
struct Prob { const char* A; const char* B; unsigned lda, ldb; size_t sAz, sBz; int K;
              unsigned hsB; int sh1, sh2; unsigned m0, m1; size_t s0, s1, s2;
    __device__ __forceinline__ const char* bbase(const Unit& u) const { return B + (size_t)u.pz * sBz + (size_t)((unsigned)u.pn & m0) * s0 + (size_t)(((unsigned)u.pn >> sh1) & m1) * s1 + (size_t)((unsigned)u.pn >> sh2) * s2; } };
__device__ __forceinline__ Prob mk_prob(const void* A, const void* B, unsigned lda, unsigned ldb, size_t sAz, size_t sBz, int K) {
    Prob p; p.A = (const char*)A; p.B = (const char*)B; p.lda = lda; p.ldb = ldb; p.sAz = sAz; p.sBz = sBz; p.K = K; p.hsB = HALF * ldb; p.sh1 = 0; p.sh2 = 31; p.m0 = 0x7fffffffu; p.m1 = 0u; p.s0 = (size_t)BM * ldb; p.s1 = 0; p.s2 = 0; return p; }

struct GridOrder {
    int nM, nN, nZ, nwg, G, c, wgm, seg;
    __device__ void init(int nM_, int nN_, int nZ_, int G_, int c_, int wgm_ = WGM, int seg_ = 1) { nM = nM_; nN = nN_; nZ = nZ_; nwg = nM * nN; G = G_; c = c_; wgm = wgm_; seg = seg_; }
    __device__ bool next(int i, Unit& u) const {
        const long L = (seg == 2) ? (long)(i >> 1) * G + c : (long)i * G + c; if (L >= (long)nwg * nZ) return false;
        u.pz = (seg == 2) ? (i & 1) : (int)(L / nwg);
        int wgid = (int)(L % nwg); { const int q = nwg / NXCD, r = nwg % NXCD, xcd = wgid % NXCD, off = wgid / NXCD; wgid = (xcd < r ? xcd * (q + 1) : r * (q + 1) + (xcd - r) * q) + off; }
        const int nig = wgm * nN, gid = wgid / nig, fm = gid * wgm, gsz = (nM - fm) < wgm ? (nM - fm) : wgm;
        u.pm = fm + ((wgid % nig) % gsz); u.pn = (wgid % nig) / gsz; return true;
    }
};

typedef __bf16 cv_bf16x2 __attribute__((ext_vector_type(2)));
typedef float cv_f32x2 __attribute__((ext_vector_type(2)));
__device__ __forceinline__ unsigned cvt_pk_bf16(float lo, float hi) { const cv_f32x2 v = {lo, hi}; return __builtin_bit_cast(unsigned, __builtin_convertvector(v, cv_bf16x2)); }
__device__ __forceinline__ float bf_lo(unsigned w) { return __uint_as_float(w << 16); }
__device__ __forceinline__ float bf_hi(unsigned w) { return __uint_as_float(w & 0xffff0000u); }
__device__ __forceinline__ float sigmoidf_(float x) { return __builtin_amdgcn_rcpf(1.0f + __builtin_amdgcn_exp2f(-1.4426950408889634f * x)); }

#define EPI_ROWS_BEGIN _Pragma("unroll") for (int ai = 0; ai < 2; ++ai) _Pragma("unroll") for (int m = 0; m < 4; ++m) { const int row = u.pm * BM + ai * HALF + wr * 64 + m * 16 + fr;
#define EPI_ROWS_END }

struct EpiBf16 {
    struct State { float rs[8]; };
    bf16_t* O; int ldc; float scale; int zrows; const unsigned long long* ss;
    __device__ __forceinline__ void init(f32x4 (&acc)[2][2][4][2], State& st, const Unit& u, int wr, int, int fr, int) const {
        if (ss) {
#pragma unroll
            for (int ai = 0; ai < 2; ++ai)
#pragma unroll
                for (int m = 0; m < 4; ++m) st.rs[ai * 4 + m] = __builtin_amdgcn_rsqf((float)ss[u.pm * BM + ai * HALF + wr * 64 + m * 16 + fr] * (1.0f / (1048576.0f * 2048.0f)) + 1e-6f); }

#pragma unroll
        for (int a = 0; a < 2; ++a)
#pragma unroll
            for (int b = 0; b < 2; ++b)
#pragma unroll
                for (int m = 0; m < 4; ++m)
#pragma unroll
                    for (int n = 0; n < 2; ++n) acc[a][b][m][n] = (f32x4){0.f, 0.f, 0.f, 0.f}; }
    __device__ __forceinline__ void operator()(const f32x4 (&acc)[2][2][4][2], const State& st, const Unit& u, int wr, int wc, int fr, int fq) const {
        const int col0 = u.pn * BM + wc * 32 + 8 * fq;
        EPI_ROWS_BEGIN
            bf16_t* rowp = O + (size_t)(u.pz * zrows + row) * ldc + col0;
            const float rs = ss ? scale * st.rs[ai * 4 + m] : scale;
#pragma unroll
            for (int bj = 0; bj < 2; ++bj) { const f32x4 v0 = acc[ai][bj][m][0] * rs, v1 = acc[ai][bj][m][1] * rs;
                u32x4 w; w.x = cvt_pk_bf16(v0[0], v0[1]); w.y = cvt_pk_bf16(v0[2], v0[3]); w.z = cvt_pk_bf16(v1[0], v1[1]); w.w = cvt_pk_bf16(v1[2], v1[3]);
                *(u32x4*)(rowp + bj * HALF) = w; }
        EPI_ROWS_END
    }
};
struct EpiSwiglu {
    struct State { float rs[8]; };
    bf16_t* O; int ldc; const unsigned long long* ss;
    __device__ __forceinline__ void init(f32x4 (&acc)[2][2][4][2], State& st, const Unit& u, int wr, int, int fr, int) const {
        {
#pragma unroll
            for (int ai = 0; ai < 2; ++ai)
#pragma unroll
                for (int m = 0; m < 4; ++m) st.rs[ai * 4 + m] = __builtin_amdgcn_rsqf((float)ss[u.pm * BM + ai * HALF + wr * 64 + m * 16 + fr] * (1.0f / (1048576.0f * 2048.0f)) + 1e-6f); }

#pragma unroll
        for (int a = 0; a < 2; ++a)
#pragma unroll
            for (int b = 0; b < 2; ++b)
#pragma unroll
                for (int m = 0; m < 4; ++m)
#pragma unroll
                    for (int n = 0; n < 2; ++n) acc[a][b][m][n] = (f32x4){0.f, 0.f, 0.f, 0.f}; }
    __device__ __forceinline__ void operator()(const f32x4 (&acc)[2][2][4][2], const State& st, const Unit& u, int wr, int wc, int fr, int fq) const {
        const int col0 = u.pn * HALF + wc * 32 + 8 * fq;
        EPI_ROWS_BEGIN
            const float rs = st.rs[ai * 4 + m];
            float h[8];
#pragma unroll
            for (int n = 0; n < 2; ++n)
#pragma unroll
                for (int e = 0; e < 4; ++e) { const float g = acc[ai][0][m][n][e] * rs, up = acc[ai][1][m][n][e] * rs; h[n * 4 + e] = g * sigmoidf_(g) * up; }
            u32x4 w; w.x = cvt_pk_bf16(h[0], h[1]); w.y = cvt_pk_bf16(h[2], h[3]); w.z = cvt_pk_bf16(h[4], h[5]); w.w = cvt_pk_bf16(h[6], h[7]);
            *(u32x4*)(O + (size_t)row * ldc + col0) = w;
        EPI_ROWS_END
    }
};
struct EpiGate {
    struct State { float rs[8]; };
    const bf16_t* G; int ldg; const bf16_t* T; bf16_t* O; int ldc; int add;
    __device__ __forceinline__ void init(f32x4 (&acc)[2][2][4][2], State&, const Unit&, int, int, int, int) const {
#pragma unroll
        for (int a = 0; a < 2; ++a)
#pragma unroll
            for (int b = 0; b < 2; ++b)
#pragma unroll
                for (int m = 0; m < 4; ++m)
#pragma unroll
                    for (int n = 0; n < 2; ++n) acc[a][b][m][n] = (f32x4){0.f, 0.f, 0.f, 0.f}; }
    __device__ __forceinline__ void operator()(const f32x4 (&acc)[2][2][4][2], const State& st, const Unit& u, int wr, int wc, int fr, int fq) const {
        const int col0 = u.pn * BM + wc * 32 + 8 * fq;
        EPI_ROWS_BEGIN
#pragma unroll
            for (int bj = 0; bj < 2; ++bj) {
                const u32x4 gw = *(const u32x4*)(G + (size_t)row * ldg + col0 + bj * HALF);
                u32x4 tw = (u32x4){0u, 0u, 0u, 0u};
                if (add) tw = *(const u32x4*)(T + (size_t)row * ldc + col0 + bj * HALF);
                float r[8];
#pragma unroll
                for (int q = 0; q < 4; ++q) {
                    const float a0 = acc[ai][bj][m][q >> 1][(q & 1) * 2], a1 = acc[ai][bj][m][q >> 1][(q & 1) * 2 + 1];
                    r[2 * q] = bf_lo(tw[q]) + sigmoidf_(bf_lo(gw[q])) * a0; r[2 * q + 1] = bf_hi(tw[q]) + sigmoidf_(bf_hi(gw[q])) * a1; }
                u32x4 w; w.x = cvt_pk_bf16(r[0], r[1]); w.y = cvt_pk_bf16(r[2], r[3]); w.z = cvt_pk_bf16(r[4], r[5]); w.w = cvt_pk_bf16(r[6], r[7]);
                *(u32x4*)(O + (size_t)row * ldc + col0 + bj * HALF) = w; }
        EPI_ROWS_END
    }
};
struct EpiGate2 {
    struct State { float rs[8]; };
    const bf16_t* Gf; const bf16_t* Ga; int ldg; bf16_t* O; int ldc;
    __device__ __forceinline__ void init(f32x4 (&acc)[2][2][4][2], State&, const Unit& u, int, int, int, int) const {
        if (u.pz != 0) return;
#pragma unroll
        for (int a = 0; a < 2; ++a)
#pragma unroll
            for (int b = 0; b < 2; ++b)
#pragma unroll
                for (int m = 0; m < 4; ++m)
#pragma unroll
                    for (int n = 0; n < 2; ++n) acc[a][b][m][n] = (f32x4){0.f, 0.f, 0.f, 0.f}; }
    __device__ __forceinline__ void operator()(f32x4 (&acc)[2][2][4][2], const State& st, const Unit& u, int wr, int wc, int fr, int fq) const {
        const int col0 = u.pn * BM + wc * 32 + 8 * fq;
        EPI_ROWS_BEGIN
#pragma unroll
            for (int bj = 0; bj < 2; ++bj) {
                const u32x4 ga = *(const u32x4*)(Ga + (size_t)row * ldg + col0 + bj * HALF);
                if (u.pz == 0) {
                    const u32x4 gf = *(const u32x4*)(Gf + (size_t)row * ldg + col0 + bj * HALF);
#pragma unroll
                    for (int q = 0; q < 4; ++q) {
                        const float e0 = __builtin_amdgcn_exp2f(-1.4426950408889634f * bf_lo(ga[q])), e1 = __builtin_amdgcn_exp2f(-1.4426950408889634f * bf_hi(ga[q]));
                        const float f0 = __builtin_amdgcn_exp2f(-1.4426950408889634f * bf_lo(gf[q])), f1 = __builtin_amdgcn_exp2f(-1.4426950408889634f * bf_hi(gf[q]));
                        acc[ai][bj][m][q >> 1][(q & 1) * 2] *= (1.0f + e0) * __builtin_amdgcn_rcpf(1.0f + f0);
                        acc[ai][bj][m][q >> 1][(q & 1) * 2 + 1] *= (1.0f + e1) * __builtin_amdgcn_rcpf(1.0f + f1); }
                } else {
                    float r[8];
#pragma unroll
                    for (int q = 0; q < 4; ++q) { r[2 * q] = sigmoidf_(bf_lo(ga[q])) * acc[ai][bj][m][q >> 1][(q & 1) * 2]; r[2 * q + 1] = sigmoidf_(bf_hi(ga[q])) * acc[ai][bj][m][q >> 1][(q & 1) * 2 + 1]; }
                    u32x4 w; w.x = cvt_pk_bf16(r[0], r[1]); w.y = cvt_pk_bf16(r[2], r[3]); w.z = cvt_pk_bf16(r[4], r[5]); w.w = cvt_pk_bf16(r[6], r[7]);
                    *(u32x4*)(O + (size_t)row * ldc + col0 + bj * HALF) = w; }
            }
        EPI_ROWS_END
    }
};
struct EpiCstep {
    struct State { float rs[8]; };
    bf16_t* X1;
    __device__ __forceinline__ void init(f32x4 (&acc)[2][2][4][2], State&, const Unit&, int, int, int, int) const {
#pragma unroll
        for (int a = 0; a < 2; ++a)
#pragma unroll
            for (int b = 0; b < 2; ++b)
#pragma unroll
                for (int m = 0; m < 4; ++m)
#pragma unroll
                    for (int n = 0; n < 2; ++n) acc[a][b][m][n] = (f32x4){0.f, 0.f, 0.f, 0.f}; }
    __device__ __forceinline__ void operator()(const f32x4 (&acc)[2][2][4][2], const State& st, const Unit& u, int wr, int wc, int fr, int fq) const {
        const int b = u.pn >> 5, s1_0 = wc * 32 + 8 * fq;
        EPI_ROWS_BEGIN
            const int gc = u.pz * 256 + (row - u.pm * BM);
#pragma unroll
            for (int bj = 0; bj < 2; ++bj) { const int s2 = 2 * (u.pn & 31) + bj;
                const f32x4 v0 = acc[ai][bj][m][0], v1 = acc[ai][bj][m][1];
                u32x4 w; w.x = cvt_pk_bf16(v0[0], v0[1]); w.y = cvt_pk_bf16(v0[2], v0[3]); w.z = cvt_pk_bf16(v1[0], v1[1]); w.w = cvt_pk_bf16(v1[2], v1[3]);
                *(u32x4*)(X1 + ((size_t)((((gc * 2 + b) * 64 + s2) * 2 + u.pm) * 128) + s1_0)) = w; }
        EPI_ROWS_END
    }
};
struct EpiS1 {
    struct State { float rs[8]; };
    bf16_t* Y2; const float* TW;
    __device__ __forceinline__ void init(f32x4 (&acc)[2][2][4][2], State&, const Unit&, int, int, int, int) const {
#pragma unroll
        for (int a = 0; a < 2; ++a)
#pragma unroll
            for (int b = 0; b < 2; ++b)
#pragma unroll
                for (int m = 0; m < 4; ++m)
#pragma unroll
                    for (int n = 0; n < 2; ++n) acc[a][b][m][n] = (f32x4){0.f, 0.f, 0.f, 0.f}; }
    __device__ __forceinline__ void operator()(const f32x4 (&acc)[2][2][4][2], const State& st, const Unit& u, int wr, int wc, int fr, int fq) const {
        const int s2_0 = (wc & 1) * 32 + 8 * fq;
#pragma unroll
        for (int m = 0; m < 4; ++m) {
            const int s1p = wr * 64 + m * 16 + fr;
            const f32x4* tp = (const f32x4*)(TW + ((size_t)s1p * 64 + s2_0) * 2);
            const f32x4 t0 = tp[0], t1 = tp[1], t2 = tp[2], t3 = tp[3];
            const float tc[8] = {t0[0], t0[2], t1[0], t1[2], t2[0], t2[2], t3[0], t3[2]}, ts[8] = {t0[1], t0[3], t1[1], t1[3], t2[1], t2[3], t3[1], t3[3]};
#pragma unroll
            for (int bj = 0; bj < 2; ++bj) {
                const int q = u.pn * 4 + bj * 2 + (wc >> 1);
                float yr[8], yi[8];
#pragma unroll
                for (int e = 0; e < 8; ++e) { const float a = acc[0][bj][m][e >> 2][e & 3], c = acc[1][bj][m][e >> 2][e & 3]; yr[e] = a * tc[e] - c * ts[e]; yi[e] = a * ts[e] + c * tc[e]; }
                u32x4 w0, w1;
                w0.x = cvt_pk_bf16(yr[0], yr[1]); w0.y = cvt_pk_bf16(yr[2], yr[3]); w0.z = cvt_pk_bf16(yr[4], yr[5]); w0.w = cvt_pk_bf16(yr[6], yr[7]);
                w1.x = cvt_pk_bf16(yi[0], yi[1]); w1.y = cvt_pk_bf16(yi[2], yi[3]); w1.z = cvt_pk_bf16(yi[4], yi[5]); w1.w = cvt_pk_bf16(yi[6], yi[7]);
                bf16_t* dst = Y2 + ((size_t)(s1p * 2048 + q) * 2) * 64 + s2_0;
                *(u32x4*)dst = w0; *(u32x4*)(dst + 64) = w1; }
        }
    }
};
struct EpiS2 {
    struct State { float rs[8]; };
    bf16_t* F; float scale;
    __device__ __forceinline__ void init(f32x4 (&acc)[2][2][4][2], State&, const Unit&, int, int, int, int) const {
#pragma unroll
        for (int a = 0; a < 2; ++a)
#pragma unroll
            for (int b = 0; b < 2; ++b)
#pragma unroll
                for (int m = 0; m < 4; ++m)
#pragma unroll
                    for (int n = 0; n < 2; ++n) acc[a][b][m][n] = (f32x4){0.f, 0.f, 0.f, 0.f}; }
    __device__ __forceinline__ void operator()(const f32x4 (&acc)[2][2][4][2], const State& st, const Unit& u, int wr, int wc, int fr, int fq) const {
        if (wr != 0) return;
        const int gt = u.pn & 3, s1p = (u.pn >> 2) & 127, b = u.pn >> 9;
        const int col0 = gt * 256 + wc * 32 + 8 * fq;
#pragma unroll
        for (int m = 0; m < 4; ++m) { const int s2p = m * 16 + fr;
            bf16_t* rowp = F + (size_t)(b * 8192 + s1p + 128 * s2p) * 1024 + col0;
#pragma unroll
            for (int bj = 0; bj < 2; ++bj) { const f32x4 v0 = acc[0][bj][m][0] * scale, v1 = acc[0][bj][m][1] * scale;
                u32x4 w; w.x = cvt_pk_bf16(v0[0], v0[1]); w.y = cvt_pk_bf16(v0[2], v0[3]); w.z = cvt_pk_bf16(v1[0], v1[1]); w.w = cvt_pk_bf16(v1[2], v1[3]);
                *(u32x4*)(rowp + bj * HALF) = w; } }
    }
};

template <class Epi, class Sched, bool ALIGN_EPI, bool SNAKE = false>
__device__ __forceinline__ void gemm_phase(PG8_LAS unsigned char* lds, const Prob g, const Sched S, const Epi E, const int tid_in) {
    const int tid = tid_in, wid = __builtin_amdgcn_readfirstlane(tid >> 6), lane = tid & 63, wr = wid >> 2, wc = wid & 3, fr = lane & 15, fq = lane >> 4;
    int K = g.K; asm volatile("" : "+s"(K)); const int nt = K / BK;
    unsigned voffA[2], voffB[2];
#pragma unroll
    for (int i = 0; i < 2; ++i) { int R, C; stage_rc(tid * 16 + i * 8192, R, C); const int Rb = (R & ~31) + perm32(R & 31);
        voffA[i] = (unsigned)R * g.lda + (unsigned)C * 2u; voffB[i] = (unsigned)Rb * g.ldb + (unsigned)C * 2u; }
    const size_t kstep = (size_t)(BK * 2);
    const size_t hstepA = (size_t)HALF * g.lda, hstepB = (size_t)g.hsB;
    const size_t tstepA = 2 * hstepA;
    const unsigned ldsw = (unsigned)wid * 1024u;
    const int aoff = lds_byte(wr * 64 + fr, fq * 8), boff = lds_byte(wc * 32 + fr, fq * 8);
#define PG8_SA(b, h) (((b) * 2 + (h)) * HTB)
#define PG8_SB(b, h) ((4 + (b) * 2 + (h)) * HTB)
#define PG8_STAGE(bufoff, gbase, voff) do { _Pragma("unroll") for (int _i = 0; _i < 2; ++_i) \
        __builtin_amdgcn_global_load_lds((const unsigned*)((const char*)(gbase) + (voff)[_i]), (PG8_LAS unsigned*)(lds + (bufoff) + ldsw + _i * 8192), 16, 0, 0); } while (0)
#define PG8_LDA(dst, b, h) do { _Pragma("unroll") for (int m = 0; m < 4; ++m) _Pragma("unroll") for (int k = 0; k < 2; ++k) dst[m][k] = *(const PG8_LAS bf16x8*)(lds + PG8_SA(b, h) + aoff + m * 2048 + k * 1024); } while (0)
#define PG8_LDB(dst, b, h) do { _Pragma("unroll") for (int n = 0; n < 2; ++n) _Pragma("unroll") for (int k = 0; k < 2; ++k) dst[n][k] = *(const PG8_LAS bf16x8*)(lds + PG8_SB(b, h) + boff + n * 2048 + k * 1024); } while (0)
#define PG8_MMA(ai, bj, At, Bt) do { __builtin_amdgcn_s_setprio(1); _Pragma("unroll") for (int m = 0; m < 4; ++m) _Pragma("unroll") for (int n = 0; n < 2; ++n) _Pragma("unroll") for (int k = 0; k < 2; ++k) \
        acc[ai][bj][m][n] = __builtin_amdgcn_mfma_f32_16x16x32_bf16(Bt[n][k], At[m][k], acc[ai][bj][m][n], 0, 0, 0); __builtin_amdgcn_s_setprio(0); } while (0)
#define PG8_WAIT_V(n) asm volatile("s_waitcnt vmcnt(" #n ")" ::: "memory")
#define PG8_WAIT_L(n) asm volatile("s_waitcnt lgkmcnt(" #n ")" ::: "memory")
#define PG8_BAR __builtin_amdgcn_s_barrier()
#define PG8_SCHED __builtin_amdgcn_sched_barrier(0)
    Unit cur, nxt; int ui = 0;
    if (!S.next(0, cur)) return;
    f32x4 acc[2][2][4][2]; typename Epi::State est;
    E.init(acc, est, cur, wr, wc, fr, fq);
    bf16x8 At[4][2], B0[2][2], B1[2][2];
    const char* cA = g.A + (size_t)cur.pz * g.sAz + (size_t)cur.pm * tstepA; const char* cB = g.bbase(cur);
    PG8_STAGE(PG8_SB(0, 0), cB, voffB); PG8_STAGE(PG8_SB(0, 1), cB + hstepB, voffB); PG8_STAGE(PG8_SA(0, 0), cA, voffA); PG8_STAGE(PG8_SA(0, 1), cA + hstepA, voffA);
    if (wr == 1) PG8_BAR;
    PG8_WAIT_V(2); PG8_BAR;
    long ksc = (long)kstep;
    PG8_STAGE(PG8_SB(1, 0), cB + kstep, voffB); PG8_STAGE(PG8_SA(1, 0), cA + kstep, voffA); PG8_STAGE(PG8_SB(1, 1), cB + hstepB + kstep, voffB);
    PG8_WAIT_V(6); PG8_BAR;
    for (;;) {
        const bool has_next = S.next(ui + 1, nxt);
        const bool nrev = SNAKE && has_next && ((ui + 1) & 1);
        const long ksn = !has_next ? ksc : (nrev ? -(long)kstep : (long)kstep);
        const size_t noff = nrev ? (size_t)(nt - 1) * kstep : 0;
        const char* nA = has_next ? g.A + (size_t)nxt.pz * g.sAz + (size_t)nxt.pm * tstepA + noff : cA; const char* nB = has_next ? g.bbase(nxt) + noff : cB;
        for (int t = 0; t < nt; t += 2) {
            const bool last = (t == nt - 2);
            const char* a1 = cA + (long)(t + 1) * ksc;
            const char* a2 = last ? nA : cA + (long)(t + 2) * ksc; const char* b2 = last ? nB : cB + (long)(t + 2) * ksc;
            const char* a3 = a2 + (last ? ksn : ksc); const char* b3 = b2 + (last ? ksn : ksc);
            PG8_LDB(B0, 0, 0); PG8_LDB(B1, 0, 1); PG8_SCHED; PG8_LDA(At, 0, 0); PG8_STAGE(PG8_SA(1, 1), a1 + hstepA, voffA);
            PG8_WAIT_V(8); PG8_WAIT_L(0); PG8_BAR; PG8_MMA(0, 0, At, B0); PG8_MMA(0, 1, At, B1); PG8_BAR; PG8_SCHED;
            PG8_LDA(At, 0, 1); PG8_STAGE(PG8_SB(0, 0), b2, voffB); PG8_STAGE(PG8_SB(0, 1), b2 + hstepB, voffB); PG8_STAGE(PG8_SA(0, 0), a2, voffA);
            PG8_WAIT_V(8); PG8_WAIT_L(0); PG8_BAR; PG8_MMA(1, 0, At, B0); PG8_MMA(1, 1, At, B1); PG8_BAR; PG8_SCHED;
            PG8_LDB(B0, 1, 0); PG8_LDB(B1, 1, 1); PG8_SCHED; PG8_LDA(At, 1, 0); PG8_STAGE(PG8_SA(0, 1), a2 + hstepA, voffA);
            PG8_WAIT_V(8); PG8_WAIT_L(0); PG8_BAR; PG8_MMA(0, 0, At, B0); PG8_MMA(0, 1, At, B1); PG8_BAR; PG8_SCHED;
            PG8_LDA(At, 1, 1); PG8_STAGE(PG8_SB(1, 0), b3, voffB); PG8_STAGE(PG8_SB(1, 1), b3 + hstepB, voffB); PG8_STAGE(PG8_SA(1, 0), a3, voffA);
            PG8_WAIT_V(8); PG8_WAIT_L(0); PG8_BAR; PG8_MMA(1, 0, At, B0); PG8_MMA(1, 1, At, B1); PG8_BAR; PG8_SCHED;
        }
        if constexpr (ALIGN_EPI) { if (wr == 0) PG8_BAR; }
        E(acc, est, cur, wr, wc, fr, fq);
        if (!has_next) break;
        E.init(acc, est, nxt, wr, wc, fr, fq);
        cur = nxt; cA = nA; cB = nB; ksc = ksn; ++ui;
        if constexpr (ALIGN_EPI) { if (wr == 1) PG8_BAR; }
    }
    PG8_WAIT_V(0);
    if constexpr (!ALIGN_EPI) { if (wr == 0) PG8_BAR; }
    PG8_BAR;
#undef PG8_SA
#undef PG8_SB
#undef PG8_STAGE
#undef PG8_LDA
#undef PG8_LDB
#undef PG8_MMA
#undef PG8_WAIT_V
#undef PG8_WAIT_L
#undef PG8_BAR
#undef PG8_SCHED
}
}

namespace att {
typedef unsigned short bf16_t;
using bf16x8 = __attribute__((ext_vector_type(8))) short;
using s16x4  = __attribute__((ext_vector_type(4))) short;
using f32x16 = __attribute__((ext_vector_type(16))) float;
using u32x4  = __attribute__((ext_vector_type(4))) unsigned;
constexpr int NW = 8, QBLK = 32, KVBLK = 64;
constexpr int LDQ = 128, LDK = 128, LDV = 128, LDO = 1024;
#define KSWZ(row, colB) ((row) * 256 + ((colB) ^ (((row) & 7) << 4)))
#define SBAR() __builtin_amdgcn_sched_barrier(0)
template <int X> __device__ __forceinline__ float sx(float v) { return __int_as_float(__builtin_amdgcn_ds_swizzle(__float_as_int(v), 0x1f | (X << 10))); }
__device__ __forceinline__ int crow(int r, int hi) { return (r & 3) + 8 * (r >> 2) + 4 * hi; }
__device__ __forceinline__ unsigned cvtpk(float lo, float hi) { return pg8::cvt_pk_bf16(lo, hi); }
__device__ __forceinline__ int v_st(int k, int c) { const int kk = (k & ~0xC) | ((k & 4) << 1) | ((k & 8) >> 1); return ((kk >> 3) * 4 + (c >> 5)) * 512 + ((kk & 7) * 32 + (c & 31)) * 2; }
__device__ __forceinline__ int v_rd_base(int lane) { return ((lane & 3) << 3) | (((lane >> 2) & 3) << 6) | (((lane >> 4) & 1) << 5) | (((lane >> 5) & 1) << 8); }
constexpr int v_rd_off(int d0, int ks, int half) { return d0 * 512 + ks * 4096 + half * 2048; }
template <int OFF> __device__ __forceinline__ s16x4 tr_read(int vb) {
  s16x4 r; asm volatile("ds_read_b64_tr_b16 %0, %1 offset:%2" : "=&v"(r) : "v"(vb), "i"(OFF) : "memory"); return r;
}
typedef __attribute__((address_space(3))) char* lptr;
typedef short v4i16_t __attribute__((ext_vector_type(4)));
#define LDSV(T, p) (*(__attribute__((address_space(3))) T*)(p))
constexpr int KSLOT = 16640, VSLOT = 16384, NSLOT = 4, K_OFF = 0, V_OFF = NSLOT * KSLOT, WS_OFF = V_OFF + NSLOT * VSLOT;
constexpr int CH = 2080;
__device__ __forceinline__ int k_img(int key, int chunk, int h) { return chunk * CH + key * 32 + ((h ^ ((key >> 3) & 1)) * 16); }
template <int OFF> __device__ __forceinline__ bf16x8 rd128(int a) { bf16x8 r; asm volatile("ds_read_b128 %0, %1 offset:%2" : "=&v"(r) : "v"(a), "i"(OFF) : "memory"); return r; }
#define LWAIT(N) do { asm volatile("s_waitcnt lgkmcnt(" #N ")" ::: "memory"); SBAR(); } while (0)
__device__ __forceinline__ s16x4 vtr(lptr p) { return __builtin_bit_cast(s16x4, __builtin_amdgcn_ds_read_tr16_b64_v4i16((__attribute__((address_space(3))) v4i16_t*)p)); }
#define PK4(P, BASE, OUT) do { unsigned a0 = cvtpk(P[BASE + 0], P[BASE + 1]), a1 = cvtpk(P[BASE + 2], P[BASE + 3]);   \
    unsigned b0 = cvtpk(P[BASE + 4], P[BASE + 5]), b1 = cvtpk(P[BASE + 6], P[BASE + 7]);                              \
    auto r0 = __builtin_amdgcn_permlane32_swap(a0, b0, false, false); auto r1 = __builtin_amdgcn_permlane32_swap(a1, b1, false, false); \
    u32x4 w = {r0[0], r1[0], r0[1], r1[1]}; OUT = *reinterpret_cast<bf16x8*>(&w); } while (0)
template <bool SHIFT>
__device__ __forceinline__ void attn_unit(const bf16_t* __restrict__ Qb, const bf16_t* __restrict__ Kh, const bf16_t* __restrict__ Vh, bf16_t* __restrict__ Ob,
                                          int seq, float negshift, float lam, const float* __restrict__ gsub, float oscale, float eps, lptr lds, const int wave_in) {
  int lane_s; asm volatile("v_mbcnt_lo_u32_b32 %0, -1, 0\n\tv_mbcnt_hi_u32_b32 %0, -1, %0" : "=v"(lane_s));
  const int wid = wave_in, lane = lane_s, tid = wid * 64 + lane, r32 = lane & 31, hi = lane >> 5, comp = wid >> 2, wq = wid & 3;
#define UNI(x) __builtin_bit_cast(float, __builtin_amdgcn_readfirstlane(__builtin_bit_cast(int, (x))))
  lam = UNI(lam); oscale = UNI(oscale); eps = UNI(eps); negshift = UNI(negshift);
#undef UNI
  float l = 0.f; f32x16 o[4] = {}; bf16x8 qr[4];
  const bf16_t* Qw = Qb + (long)(wq * QBLK + r32) * LDQ + comp * 64 + hi * 8;
#pragma unroll
  for (int d0 = 0; d0 < 4; ++d0) qr[d0] = *reinterpret_cast<const bf16x8*>(Qw + d0 * 16);
  const int sr = tid >> 4, sc = (tid & 15) * 8;
  const lptr kwr = lds + K_OFF + k_img(sr, sc >> 4, (sc >> 3) & 1);
  const lptr vwr = lds + V_OFF + v_st(sr, sc);
  const lptr krd = lds + K_OFF + k_img(r32, comp * 4, hi);
  const lptr vrd = lds + V_OFF + v_rd_base(lane);
  unsigned voffK = (unsigned)(sr * LDK + sc) * 2u, voffV = (unsigned)(sr * LDV + sc) * 2u; asm volatile("" : "+v"(voffK), "+v"(voffV));
  const char* kg = (const char*)Kh; const char* vg = (const char*)Vh;
  bf16x8 vs0, vs1, ks0, ks1;
#define SLOAD() do { vs0 = *reinterpret_cast<const bf16x8*>(vg + voffV); vs1 = *reinterpret_cast<const bf16x8*>(vg + (size_t)32 * LDV * 2 + voffV); \
    ks0 = *reinterpret_cast<const bf16x8*>(kg + voffK); ks1 = *reinterpret_cast<const bf16x8*>(kg + (size_t)32 * LDK * 2 + voffK); kg += (size_t)KVBLK * LDK * 2; vg += (size_t)KVBLK * LDV * 2; } while (0)
#define SWRITE(sl) do { LDSV(bf16x8, vwr + (sl) * VSLOT) = vs0; LDSV(bf16x8, vwr + (sl) * VSLOT + 8192) = vs1; LDSV(bf16x8, kwr + (sl) * KSLOT) = ks0; LDSV(bf16x8, kwr + (sl) * KSLOT + 1024) = ks1; } while (0)
#define MSTEP(SC, SN, PP, PC, KO, VS, H, DO_QK, DO_PV) do { \
    bf16x8 kf[4]; s16x4 vl[4][2], vh[4][2]; \
    if (DO_QK) { _Pragma("unroll") for (int d0 = 0; d0 < 4; ++d0) kf[d0] = LDSV(const bf16x8, krd + (KO) + d0 * CH); } \
    if (DO_PV) { _Pragma("unroll") for (int d0 = 0; d0 < 4; ++d0) _Pragma("unroll") for (int ks = 0; ks < 2; ++ks) { \
        vl[d0][ks] = vtr(vrd + (VS) * VSLOT + v_rd_off(d0, 2 * (H) + ks, 0)); vh[d0][ks] = vtr(vrd + (VS) * VSLOT + v_rd_off(d0, 2 * (H) + ks, 1)); } } \
    if (DO_QK) { const f32x16 z = {}; SN = __builtin_amdgcn_mfma_f32_32x32x16_bf16(kf[0], qr[0], z, 0, 0, 0); \
        _Pragma("unroll") for (int d0 = 1; d0 < 4; ++d0) SN = __builtin_amdgcn_mfma_f32_32x32x16_bf16(kf[d0], qr[d0], SN, 0, 0, 0); } \
    { _Pragma("unroll") for (int r = 0; r < 16; ++r) SC[r] = __builtin_amdgcn_exp2f(SHIFT ? SC[r] + negshift : SC[r]); \
      float ps = 0.f; _Pragma("unroll") for (int r = 0; r < 16; ++r) ps += SC[r]; l += ps; \
      PK4(SC, 0, PC[0]); PK4(SC, 8, PC[1]); } \
    if (DO_PV) { _Pragma("unroll") for (int d0 = 0; d0 < 4; ++d0) _Pragma("unroll") for (int ks = 0; ks < 2; ++ks) { \
        const bf16x8 vf = (bf16x8){vl[d0][ks][0], vl[d0][ks][1], vl[d0][ks][2], vl[d0][ks][3], vh[d0][ks][0], vh[d0][ks][1], vh[d0][ks][2], vh[d0][ks][3]}; \
        o[d0] = __builtin_amdgcn_mfma_f32_32x32x16_bf16(PP[ks], vf, o[d0], 0, 0, 0); } } \
      \
    __builtin_amdgcn_sched_group_barrier(0x100, 20, 0); if (SHIFT) __builtin_amdgcn_sched_group_barrier(0x002, 16, 0); \
    _Pragma("unroll") for (int i_ = 0; i_ < 8; ++i_) { __builtin_amdgcn_sched_group_barrier(0x008, 1, 0); __builtin_amdgcn_sched_group_barrier(0x400, 2, 0); __builtin_amdgcn_sched_group_barrier(0x002, 2, 0); } \
    _Pragma("unroll") for (int i_ = 0; i_ < 4; ++i_) { __builtin_amdgcn_sched_group_barrier(0x008, 1, 0); __builtin_amdgcn_sched_group_barrier(0x002, 3, 0); } \
    SBAR(); } while (0)
#define STEP(TM, DO_PREV, DO_NEXT, DO_WR, DO_LD) do { \
    __syncthreads(); \
    MSTEP(sA, sB, pY, pX, (TM) * KSLOT + 1024, ((TM) + 3) & 3, 1, true, DO_PREV); \
    if (DO_WR) SWRITE(((TM) + 2) & 3); \
    if (DO_LD) SLOAD(); \
    MSTEP(sB, sA, pX, pY, (((TM) + 1) & 3) * KSLOT, TM, 0, DO_NEXT, true); } while (0)
  const int NT = seq / KVBLK;
  f32x16 sA, sB; bf16x8 pX[2], pY[2];
  SLOAD(); SWRITE(0); SLOAD(); SWRITE(1); SLOAD();
  __syncthreads();
  { const f32x16 z = {}; sA = __builtin_amdgcn_mfma_f32_32x32x16_bf16(LDSV(const bf16x8, krd), qr[0], z, 0, 0, 0);
#pragma unroll
    for (int d0 = 1; d0 < 4; ++d0) sA = __builtin_amdgcn_mfma_f32_32x32x16_bf16(LDSV(const bf16x8, krd + d0 * CH), qr[d0], sA, 0, 0, 0); }
  STEP(0, false, true, true, true);
  STEP(1, true, true, true, true); STEP(2, true, true, true, true); STEP(3, true, true, true, true);
  for (int t = 4; t + 4 < NT; t += 4) {
    STEP(0, true, true, true, true); STEP(1, true, true, true, true); STEP(2, true, true, true, true); STEP(3, true, true, true, true);
  }
  STEP(0, true, true, true, true);
  STEP(1, true, true, true, false);
  STEP(2, true, true, false, false);
  STEP(3, true, false, false, false);
  { s16x4 vl[4][2], vh[4][2];
#pragma unroll
    for (int d0 = 0; d0 < 4; ++d0)
#pragma unroll
      for (int ks = 0; ks < 2; ++ks) { vl[d0][ks] = vtr(vrd + 3 * VSLOT + v_rd_off(d0, 2 + ks, 0)); vh[d0][ks] = vtr(vrd + 3 * VSLOT + v_rd_off(d0, 2 + ks, 1)); }
#pragma unroll
    for (int d0 = 0; d0 < 4; ++d0)
#pragma unroll
      for (int ks = 0; ks < 2; ++ks) { const bf16x8 vf = (bf16x8){vl[d0][ks][0], vl[d0][ks][1], vl[d0][ks][2], vl[d0][ks][3], vh[d0][ks][0], vh[d0][ks][1], vh[d0][ks][2], vh[d0][ks][3]};
        o[d0] = __builtin_amdgcn_mfma_f32_32x32x16_bf16(pY[ks], vf, o[d0], 0, 0, 0); } }
#undef MSTEP
#undef SLOAD
#undef SWRITE
#undef STEP
  { auto rr = __builtin_amdgcn_permlane32_swap(__float_as_uint(l), __float_as_uint(l), false, false); l = __uint_as_float(rr[0]) + __uint_as_float(rr[1]); }
  int lane_e; asm volatile("v_mbcnt_lo_u32_b32 %0, -1, 0\n\tv_mbcnt_hi_u32_b32 %0, -1, %0" : "=v"(lane_e));
  const int r32e = lane_e & 31, hie = lane_e >> 5;
  __attribute__((address_space(3))) float* wse = (__attribute__((address_space(3))) float*)(lds + WS_OFF) + wid * 64;
  if (hie == 0) wse[r32e] = l;
  __syncthreads();
  lptr xb = lds + wq * (32 * 128 * 4) + (4 * hie * 128 + r32e) * 4;
  lptr wl = (lptr)wse + 4 * hie * 4;
  asm volatile("" : "+v"(xb), "+v"(wl));
#define CR(r) (((r) & 3) + 8 * ((r) >> 2))
  if (comp == 1) {
#pragma unroll
    for (int r = 0; r < 16; ++r) { const float c1 = lam * __builtin_amdgcn_rcpf(LDSV(float, wl + CR(r) * 4));
#pragma unroll
      for (int d0 = 0; d0 < 4; ++d0) LDSV(float, xb + CR(r) * 512 + d0 * 128) = o[d0][r] * c1; }
  }
  __syncthreads();
  if (comp == 0) {
    float gs[4];
#pragma unroll
    for (int d0 = 0; d0 < 4; ++d0) gs[d0] = gsub[d0 * 32 + r32e] * oscale;
    char* Ow = (char*)(Ob + (long)(wq * QBLK) * LDO);
    unsigned lofs = (unsigned)((4 * hie * LDO + r32e) * 2); asm volatile("" : "+v"(lofs));
#pragma unroll
    for (int r = 0; r < 16; ++r) {
      const float c0 = __builtin_amdgcn_rcpf(LDSV(float, wl + CR(r) * 4));
      float v[4]; float ss = 0.f;
#pragma unroll
      for (int d0 = 0; d0 < 4; ++d0) { v[d0] = o[d0][r] * c0 - LDSV(float, xb + CR(r) * 512 + d0 * 128); ss += v[d0] * v[d0]; }
      ss += sx<1>(ss); ss += sx<2>(ss); ss += sx<4>(ss); ss += sx<8>(ss); ss += sx<16>(ss);
      const float rs = __builtin_amdgcn_rsqf(ss * (1.0f / 128.0f) + eps);
#pragma unroll
      for (int d0 = 0; d0 < 4; ++d0) { const unsigned w = cvtpk(v[d0] * rs * gs[d0], 0.f); *(__attribute__((address_space(1))) bf16_t*)(Ow + (size_t)(CR(r) * LDO * 2 + d0 * 64) + lofs) = (bf16_t)(w & 0xffffu); }
    }
  }
#undef CR
  __syncthreads();
}
#undef LDSV
#undef KSWZ
#undef SBAR
}

constexpr int NWAVES = 8;
constexpr int BATCH = 2, SEQ = 8192, DM = 2048, DEPTH = 4, M = BATCH * SEQ;
constexpr int DFF = 5632, DIN = 8192, DFOUR = 1024, NHEAD = 8, QKD = 64, VD = 128;
constexpr float EPS = 1e-6f;
constexpr int ZC_UF = 0, ZC_Q = 1024, ZC_K = 2048, ZC_V = 3072, ZC_GF = 4096, ZC_GA = 6144;

constexpr size_t MiB = 1u << 20;
constexpr size_t WS_CTL = 0, CTL_ZERO_BYTES = 2 * MiB;
constexpr size_t WS_ROPE = 2 * MiB;
constexpr size_t WS_DFTC = 2 * MiB + 512 * 1024;
constexpr size_t WS_WBIG = WS_DFTC + 256 * 1024;
constexpr size_t WS_W2P  = WS_WBIG + 128 * 1024;
constexpr size_t WS_TW   = WS_W2P + 64 * 1024;
constexpr size_t WS_W = 3 * MiB, W_LAYER = 180 * MiB;
constexpr size_t WL_GUA = 0, WL_DA = 44 * MiB, WL_IN = 66 * MiB, WL_PF = 98 * MiB, WL_PA = 102 * MiB, WL_WO = 106 * MiB, WL_GUB = 114 * MiB, WL_DB = 158 * MiB;
constexpr size_t WS_H = WS_W + 4 * W_LAYER;
constexpr size_t WS_Z = WS_H + 64 * MiB;
constexpr size_t WS_QN = WS_Z + 256 * MiB, WS_KN = WS_QN + 32 * MiB;
constexpr size_t WS_ZT = WS_KN + 32 * MiB;
constexpr size_t WS_Y2 = WS_ZT + 64 * MiB;
constexpr size_t WS_F = WS_Y2 + 64 * MiB, WS_O = WS_F + 32 * MiB, WS_VN = WS_O + 32 * MiB, WS_END = WS_VN + 32 * MiB;
static_assert(WS_TW + 64 * 1024 <= WS_W, "tables fit below the weights");
constexpr int CW_BAR = 4096;
constexpr size_t WS_SSACC = 64 * 1024;
constexpr size_t WS_SSFFA = WS_SSACC + 8 * 131072;
static_assert(WS_SSFFA + 4 * 131072 <= CTL_ZERO_BYTES, "statistics inside the control region");
constexpr float SS_FIX = 1048576.0f, SS_INV = 1.0f / (1048576.0f * 2048.0f);

constexpr int RING_OFF = 0, RING_BYTES = 131072;
constexpr int LDSCTL_OFF = RING_BYTES + 4096, MISC_OFF = LDSCTL_OFF + 320;
constexpr int LDS_BYTES = 147456;

#define GAS __attribute__((address_space(1)))
#define LAS __attribute__((address_space(3)))
typedef unsigned short bf16;
typedef unsigned v4u __attribute__((ext_vector_type(4)));
typedef float f32x4 __attribute__((ext_vector_type(4)));
typedef GAS unsigned gu32;
#define RLX_AGENT __ATOMIC_RELAXED, __HIP_MEMORY_SCOPE_AGENT
#define LDS_WAIT() asm volatile("s_waitcnt lgkmcnt(0)" ::: "memory")
__device__ __forceinline__ unsigned f2bf(float f) { unsigned u = __builtin_bit_cast(unsigned, f); return (u + 0x7fffu + ((u >> 16) & 1u)) >> 16; }
__device__ __forceinline__ unsigned pk2(float lo, float hi) { return f2bf(lo) | (f2bf(hi) << 16); }

#define XB_TMO      128
#define XB_XCNT(j)  (256  + 64 * (j))
#define XB_XSUB(j)  (1280 + 64 * (j))
#define XB_XGEN(j)  (2304 + 64 * (j))
#define XB_TOP      3328
#define XB_TOPGEN   3392
#define XCD_BAR_WORDS 3456
#define XB_SPIN_CAP (1u << 18)
__device__ __forceinline__ unsigned xb_ld(unsigned* p)              { return __hip_atomic_load(p, __ATOMIC_RELAXED, __HIP_MEMORY_SCOPE_AGENT); }
__device__ __forceinline__ unsigned xb_add(unsigned* p, unsigned v) { return __hip_atomic_fetch_add(p, v, __ATOMIC_RELAXED, __HIP_MEMORY_SCOPE_AGENT); }
__device__ __forceinline__ unsigned xb_xcc_id() { return (unsigned)__builtin_amdgcn_s_getreg((3 << 11) | 20) & 0xFu; }
#define XB_SPIN(cond, bar) do { unsigned _sp = 0; while (cond) { __builtin_amdgcn_s_sleep(1); \
    if ((++_sp & 255u) == 0u) { if (xb_ld(&(bar)[XB_TMO])) break; if (_sp > XB_SPIN_CAP) { atomicAdd(&(bar)[XB_TMO], 1u); break; } } } } while (0)
struct XcdBarrier { unsigned* bar; unsigned x; volatile LAS unsigned* st; };
__device__ __forceinline__ XcdBarrier xcd_barrier_post(unsigned* bar, volatile LAS unsigned* st) {
    XcdBarrier b; b.bar = bar; b.x = xb_xcc_id(); b.st = st;
    if (threadIdx.x == 0) (void)xb_add(&bar[XB_XCNT(b.x)], 1u);
    return b;
}
__device__ __forceinline__ void xcd_barrier_complete(unsigned* bar, unsigned x, unsigned& nloc, unsigned& nx) {
    const unsigned G = gridDim.x * gridDim.y * gridDim.z;
    unsigned sum, cnt, mine, sp = 0u;
    for (;;) {
        sum = 0u; cnt = 0u; mine = 0u;
#pragma unroll
        for (unsigned j = 0; j < 16; ++j) { const unsigned c = xb_ld(&bar[XB_XCNT(j)]); sum += c; cnt += (c > 0u) ? 1u : 0u; mine = (j == x) ? c : mine; }
        if (sum == G) break;
        __builtin_amdgcn_s_sleep(1);
        if ((++sp & 255u) == 0u) { if (xb_ld(&bar[XB_TMO])) break; if (sp > XB_SPIN_CAP) { atomicAdd(&bar[XB_TMO], 1u); break; } }
    }
    nloc = mine > 0u ? mine : 1u; nx = cnt > 0u ? cnt : 1u;
}
__device__ __forceinline__ void xcd_barrier(const XcdBarrier& b) {
    asm volatile("s_waitcnt vmcnt(0)" ::: "memory");
    __syncthreads();
    if (threadIdx.x == 0) {
        unsigned* bar = b.bar;
        __builtin_amdgcn_s_waitcnt(0);
        unsigned nloc = b.st[0], nx = b.st[1];
        if (nloc == 0u) { xcd_barrier_complete(bar, b.x, nloc, nx); b.st[0] = nloc; b.st[1] = nx; }
        const unsigned old = xb_add(&bar[XB_XSUB(b.x)], 1u);
        const unsigned gen = old / nloc;
        if (old + 1u == (gen + 1u) * nloc) {
            __builtin_amdgcn_fence(__ATOMIC_RELEASE, "agent");
            asm volatile("s_waitcnt vmcnt(0)" ::: "memory");
            const unsigned og = xb_add(&bar[XB_TOP], 1u);
            const unsigned tg = og / nx;
            if (og + 1u == (tg + 1u) * nx) xb_add(&bar[XB_TOPGEN], 1u);
            else XB_SPIN(xb_ld(&bar[XB_TOPGEN]) == tg, bar);
            __builtin_amdgcn_fence(__ATOMIC_ACQUIRE, "agent");
            xb_add(&bar[XB_XGEN(b.x)], 1u);
            asm volatile("s_waitcnt vmcnt(0)" ::: "memory");
        } else {
            XB_SPIN(xb_ld(&bar[XB_XGEN(b.x)]) == gen, bar);
            __builtin_amdgcn_fence(__ATOMIC_ACQUIRE, "agent");
            asm volatile("s_waitcnt vmcnt(0)" ::: "memory");
        }
    }
    __syncthreads();
}

template <int X> __device__ __forceinline__ float swz_xor(float v) { return __int_as_float(__builtin_amdgcn_ds_swizzle(__float_as_int(v), 0x1f | (X << 10))); }
__device__ __forceinline__ float half_swap(float v) { auto rr = __builtin_amdgcn_permlane32_swap(__float_as_uint(v), __float_as_uint(v), false, false); return __uint_as_float(rr[0]) + __uint_as_float(rr[1]) - v; }
__device__ __forceinline__ float wave_sum(float v) {
    v += swz_xor<1>(v); v += swz_xor<2>(v); v += swz_xor<4>(v); v += swz_xor<8>(v); v += swz_xor<16>(v);
    { auto rr = __builtin_amdgcn_permlane32_swap(__float_as_uint(v), __float_as_uint(v), false, false); v = __uint_as_float(rr[0]) + __uint_as_float(rr[1]); }
    return v;
}
__device__ __forceinline__ float wave_max(float v) {
    v = fmaxf(v, swz_xor<1>(v)); v = fmaxf(v, swz_xor<2>(v)); v = fmaxf(v, swz_xor<4>(v)); v = fmaxf(v, swz_xor<8>(v)); v = fmaxf(v, swz_xor<16>(v));
    { auto rr = __builtin_amdgcn_permlane32_swap(__float_as_uint(v), __float_as_uint(v), false, false); v = fmaxf(__uint_as_float(rr[0]), __uint_as_float(rr[1])); }
    return v;
}
__device__ __forceinline__ void transpose_item(const float* W, int K, int N, bf16* WT, int map, LAS float* scr, int item, int lane, const float* gk = nullptr) {
    const int nblk = N / 32, kb = item / nblk, nb = item % nblk, k0 = 64 * kb, n0 = 32 * nb;
    const int r0 = (map == 0 || map == 3) ? n0 : (256 * (n0 >> 7) + (n0 & 127) + (map == 2 ? 128 : 0));
    const bool qkperm = (map == 3) && n0 >= 1024 && n0 < 3072;
#pragma unroll 8
    for (int i = 0; i < 32; ++i) { const int kk = 2 * i + (lane >> 5); scr[kk * 33 + (lane & 31)] = W[(size_t)(k0 + kk) * N + n0 + (lane & 31)]; }
    LDS_WAIT(); asm volatile("" ::: "memory");
    const int c = lane & 7;
    f32x4 ga = (f32x4){1.f, 1.f, 1.f, 1.f}, gb = ga;
    if (gk) { ga = *(const GAS f32x4*)(gk + k0 + 8 * c); gb = *(const GAS f32x4*)(gk + k0 + 8 * c + 4); }
#pragma unroll
    for (int j = 0; j < 4; ++j) { const int n = (lane >> 3) + 8 * j; const LAS float* s = scr + (8 * c) * 33 + n;
        v4u o; o.x = pk2(s[0 * 33] * ga.x, s[1 * 33] * ga.y); o.y = pk2(s[2 * 33] * ga.z, s[3 * 33] * ga.w); o.z = pk2(s[4 * 33] * gb.x, s[5 * 33] * gb.y); o.w = pk2(s[6 * 33] * gb.z, s[7 * 33] * gb.w);
        int rr = r0 + n;
        if (qkperm) { const int cc = n0 + n - 1024, hc = cc >> 6, d = cc & 63; rr = 1024 + 256 * (hc >> 2) + 128 * ((d >> 3) & 1) + 32 * (hc & 3) + 8 * (d >> 4) + 4 * ((d >> 2) & 1) + (d & 3); }
        *(GAS v4u*)(WT + (size_t)rr * K + k0 + 8 * c) = o; }
    LDS_WAIT(); asm volatile("" ::: "memory");
}
__device__ __forceinline__ void rms_row_to_bf16(const float* xrow, const f32x4 (&g)[8], bf16* orow, int lane) {
    const GAS f32x4* xr = (const GAS f32x4*)xrow + lane;
    f32x4 v[8]; float s = 0.f;
#pragma unroll
    for (int j = 0; j < 8; ++j) { v[j] = xr[64 * j]; s += (v[j].x * v[j].x + v[j].y * v[j].y) + (v[j].z * v[j].z + v[j].w * v[j].w); }
    const float rstd = 1.f / sqrtf(wave_sum(s) * (1.f / DM) + EPS);
    GAS unsigned long long* o8 = (GAS unsigned long long*)orow + lane;
#pragma unroll
    for (int j = 0; j < 8; ++j) { const f32x4 y = v[j] * rstd * g[j]; o8[64 * j] = (unsigned long long)pk2(y.x, y.y) | ((unsigned long long)pk2(y.z, y.w) << 32); }
}

__device__ __forceinline__ float row_to_bf16_ss(const float* xrow, bf16* orow, int lane) {
    const GAS f32x4* xr = (const GAS f32x4*)xrow + lane;
    GAS unsigned long long* o8 = (GAS unsigned long long*)orow + lane;
    float s = 0.f;
#pragma unroll
    for (int j = 0; j < 8; ++j) { const f32x4 v = xr[64 * j]; s += (v.x * v.x + v.y * v.y) + (v.z * v.z + v.w * v.w); o8[64 * j] = (unsigned long long)pk2(v.x, v.y) | ((unsigned long long)pk2(v.z, v.w) << 32); }
    return wave_sum(s);
}

struct Args { const float* in[22]; float* out; unsigned char* ws; int ph_lo, ph_hi; };


struct EpiWin {
    struct State { float rs[8]; };
    const Args* ka; const unsigned long long* ss; const float* gq; const float* gk;
    __device__ __forceinline__ void init(pg8::f32x4 (&acc)[2][2][4][2], State& st, const pg8::Unit& u, int wr, int, int fr, int) const {
        using pg8::f32x4; using pg8::BM; using pg8::HALF;
#pragma unroll
        for (int ai = 0; ai < 2; ++ai)
#pragma unroll
            for (int m = 0; m < 4; ++m) st.rs[ai * 4 + m] = __builtin_amdgcn_rsqf((float)ss[u.pm * BM + ai * HALF + wr * 64 + m * 16 + fr] * (1.0f / (1048576.0f * 2048.0f)) + 1e-6f);
#pragma unroll
        for (int a = 0; a < 2; ++a)
#pragma unroll
            for (int b = 0; b < 2; ++b)
#pragma unroll
                for (int m = 0; m < 4; ++m)
#pragma unroll
                    for (int n = 0; n < 2; ++n) acc[a][b][m][n] = (f32x4){0.f, 0.f, 0.f, 0.f};
    }
    __device__ __forceinline__ void operator()(const pg8::f32x4 (&acc)[2][2][4][2], const State& st, const pg8::Unit& u, int wr, int wc, int fr, int fq) const {
        using pg8::f32x4; using pg8::u32x4; using pg8::BM; using pg8::HALF; using pg8::cvt_pk_bf16;
        GAS unsigned char* wsb = (GAS unsigned char*)ka->ws;
        if (u.pn < 4 || u.pn >= 16) {
            GAS bf16* Z = (GAS bf16*)(wsb + WS_Z); const int col0 = u.pn * BM + wc * 32 + 8 * fq;
#pragma unroll
            for (int ai = 0; ai < 2; ++ai)
#pragma unroll
                for (int m = 0; m < 4; ++m) { const int row = u.pm * BM + ai * HALF + wr * 64 + m * 16 + fr; const float rs = st.rs[ai * 4 + m];
#pragma unroll
                    for (int bj = 0; bj < 2; ++bj) { const f32x4 v0 = acc[ai][bj][m][0] * rs, v1 = acc[ai][bj][m][1] * rs;
                        u32x4 w; w.x = cvt_pk_bf16(v0[0], v0[1]); w.y = cvt_pk_bf16(v0[2], v0[3]); w.z = cvt_pk_bf16(v1[0], v1[1]); w.w = cvt_pk_bf16(v1[2], v1[3]);
                        *(GAS u32x4*)(Z + (size_t)row * DIN + col0 + bj * HALF) = w; } }
        } else if (u.pn >= 12) {
            GAS bf16* V = (GAS bf16*)(wsb + WS_VN);
#pragma unroll
            for (int ai = 0; ai < 2; ++ai)
#pragma unroll
                for (int m = 0; m < 4; ++m) { const int row = u.pm * BM + ai * HALF + wr * 64 + m * 16 + fr; const float rs = st.rs[ai * 4 + m]; const int b = row >> 13, sq = row & 8191;
#pragma unroll
                    for (int bj = 0; bj < 2; ++bj) { const f32x4 v0 = acc[ai][bj][m][0] * rs, v1 = acc[ai][bj][m][1] * rs;
                        u32x4 w; w.x = cvt_pk_bf16(v0[0], v0[1]); w.y = cvt_pk_bf16(v0[2], v0[3]); w.z = cvt_pk_bf16(v1[0], v1[1]); w.w = cvt_pk_bf16(v1[2], v1[3]);
                        *(GAS u32x4*)(V + ((size_t)((b * NHEAD + 2 * (u.pn - 12) + bj) * SEQ + sq) * 128) + wc * 32 + 8 * fq) = w; } }
        } else {
            const int hca = 4 * (u.pn - 4) + wc, isk = hca >> 4, hc = hca & 15, hh = hc >> 1, cmp = hc & 1;
            GAS bf16* D = (GAS bf16*)(wsb + (isk ? WS_KN : WS_QN)); const GAS float* gg = (const GAS float*)(isk ? gk : gq) + 16 * fq;
            const GAS float* rope = (const GAS float*)(wsb + WS_ROPE);
            f32x4 g4[2][2];
#pragma unroll
            for (int bj = 0; bj < 2; ++bj)
#pragma unroll
                for (int n = 0; n < 2; ++n) g4[bj][n] = *(const GAS f32x4*)(gg + 8 * bj + 4 * n);
            const float qs = isk ? 1.0f : 0.125f * 1.4426950408889634f;
#pragma unroll
            for (int ai = 0; ai < 2; ++ai)
#pragma unroll
                for (int m = 0; m < 4; ++m) { const int row = u.pm * BM + ai * HALF + wr * 64 + m * 16 + fr; const float rs = st.rs[ai * 4 + m]; const int b = row >> 13, sq = row & 8191;
                    f32x4 x[2][2]; float q2 = 0.f;
#pragma unroll
                    for (int bj = 0; bj < 2; ++bj)
#pragma unroll
                        for (int n = 0; n < 2; ++n) { x[bj][n] = acc[ai][bj][m][n] * rs; q2 += (x[bj][n][0] * x[bj][n][0] + x[bj][n][1] * x[bj][n][1]) + (x[bj][n][2] * x[bj][n][2] + x[bj][n][3] * x[bj][n][3]); }
                    q2 += __int_as_float(__builtin_amdgcn_ds_swizzle(__float_as_int(q2), 0x1f | (16 << 10)));
                    { auto rr = __builtin_amdgcn_permlane32_swap(__float_as_uint(q2), __float_as_uint(q2), false, false); q2 = __uint_as_float(rr[0]) + __uint_as_float(rr[1]); }
                    const float rh = __builtin_amdgcn_rsqf(q2 * (1.0f / 64.0f) + 1e-6f);
#pragma unroll
                    for (int bj = 0; bj < 2; ++bj)
#pragma unroll
                        for (int n = 0; n < 2; ++n) x[bj][n] = x[bj][n] * rh * g4[bj][n];
                    if (fq == 0) {
                        const f32x4 c0 = *(const GAS f32x4*)(rope + sq * 16), c1 = *(const GAS f32x4*)(rope + sq * 16 + 4), s0 = *(const GAS f32x4*)(rope + sq * 16 + 8), s1 = *(const GAS f32x4*)(rope + sq * 16 + 12);
                        const f32x4 a0 = x[0][0], a1 = x[0][1], b0 = x[1][0], b1 = x[1][1];
                        x[0][0] = a0 * c0 - b0 * s0; x[0][1] = a1 * c1 - b1 * s1; x[1][0] = b0 * c0 + a0 * s0; x[1][1] = b1 * c1 + a1 * s1; }
                    GAS bf16* dp = D + ((size_t)((b * NHEAD + hh) * SEQ + sq) * 128) + cmp * 64 + 16 * fq;
#pragma unroll
                    for (int bj = 0; bj < 2; ++bj) { const f32x4 v0 = x[bj][0] * qs, v1 = x[bj][1] * qs;
                        u32x4 w; w.x = cvt_pk_bf16(v0[0], v0[1]); w.y = cvt_pk_bf16(v0[2], v0[3]); w.z = cvt_pk_bf16(v1[0], v1[1]); w.w = cvt_pk_bf16(v1[2], v1[3]);
                        *(GAS u32x4*)(dp + 8 * bj) = w; } }
        }
    }
};
template <int ALPHA2> struct EpiResid {
    struct State { };
    const Args* ka; int base_in; unsigned ss_off;
    __device__ __forceinline__ void init(pg8::f32x4 (&acc)[2][2][4][2], State&, const pg8::Unit& u, int wr, int wc, int fr, int fq) const {
        using pg8::f32x4; using pg8::BM; using pg8::HALF;
        const int col0 = u.pn * BM + wc * 32 + 8 * fq;
        if (base_in) {
            const GAS float* base = (const GAS float*)ka->in[0];
#pragma unroll
            for (int ai = 0; ai < 2; ++ai)
#pragma unroll
                for (int m = 0; m < 4; ++m) { const size_t off = (size_t)(u.pm * BM + ai * HALF + wr * 64 + m * 16 + fr) * DM + col0;
#pragma unroll
                    for (int bj = 0; bj < 2; ++bj)
#pragma unroll
                        for (int n = 0; n < 2; ++n) acc[ai][bj][m][n] = *(const GAS f32x4*)(base + off + bj * HALF + 4 * n) * (2.0f / ALPHA2); }
        } else {
            const GAS bf16* xb = (const GAS bf16*)((GAS unsigned char*)ka->ws + WS_H);
#pragma unroll
            for (int ai = 0; ai < 2; ++ai)
#pragma unroll
                for (int m = 0; m < 4; ++m) { const size_t off = (size_t)(u.pm * BM + ai * HALF + wr * 64 + m * 16 + fr) * DM + col0;
#pragma unroll
                    for (int bj = 0; bj < 2; ++bj) { const pg8::u32x4 w = *(const GAS pg8::u32x4*)(xb + off + bj * HALF);
                        acc[ai][bj][m][0] = (f32x4){pg8::bf_lo(w.x), pg8::bf_hi(w.x), pg8::bf_lo(w.y), pg8::bf_hi(w.y)} * (2.0f / ALPHA2);
                        acc[ai][bj][m][1] = (f32x4){pg8::bf_lo(w.z), pg8::bf_hi(w.z), pg8::bf_lo(w.w), pg8::bf_hi(w.w)} * (2.0f / ALPHA2); } }
        }
    }
    __device__ __forceinline__ void operator()(const pg8::f32x4 (&acc)[2][2][4][2], const State& st, const pg8::Unit& u, int wr, int wc, int fr, int fq) const {
        using pg8::f32x4; using pg8::u32x4; using pg8::BM; using pg8::HALF;
        GAS unsigned char* wsb = (GAS unsigned char*)ka->ws; GAS bf16* xb = (GAS bf16*)(wsb + WS_H); GAS unsigned long long* ssacc = (GAS unsigned long long*)(wsb + ss_off);
        const float alpha = 0.5f * ALPHA2;
        const int col0 = u.pn * BM + wc * 32 + 8 * fq;
#pragma unroll
        for (int ai = 0; ai < 2; ++ai)
#pragma unroll
            for (int m = 0; m < 4; ++m) { const int row = u.pm * BM + ai * HALF + wr * 64 + m * 16 + fr;
            const size_t off = (size_t)row * DM + col0;
            float q = 0.f;
#pragma unroll
            for (int bj = 0; bj < 2; ++bj) { f32x4 b[2];
#pragma unroll
                for (int n = 0; n < 2; ++n) { b[n] = acc[ai][bj][m][n] * alpha;
                    q += (b[n][0] * b[n][0] + b[n][1] * b[n][1]) + (b[n][2] * b[n][2] + b[n][3] * b[n][3]); }
                u32x4 w; w.x = pg8::cvt_pk_bf16(b[0][0], b[0][1]); w.y = pg8::cvt_pk_bf16(b[0][2], b[0][3]); w.z = pg8::cvt_pk_bf16(b[1][0], b[1][1]); w.w = pg8::cvt_pk_bf16(b[1][2], b[1][3]);
                *(GAS u32x4*)(xb + off + bj * HALF) = w; }
            q += __int_as_float(__builtin_amdgcn_ds_swizzle(__float_as_int(q), 0x1f | (16 << 10)));
            { auto rr = __builtin_amdgcn_permlane32_swap(__float_as_uint(q), __float_as_uint(q), false, false); q = __uint_as_float(rr[0]) + __uint_as_float(rr[1]); }
            if (fq == 0) __hip_atomic_fetch_add(ssacc + row, (unsigned long long)(q * SS_FIX + 0.5f), __ATOMIC_RELAXED, __HIP_MEMORY_SCOPE_AGENT);
        }
    }
};


__global__ void __launch_bounds__(NWAVES * 64, 2) enc_fwd(Args args) {
    extern __shared__ __attribute__((aligned(16))) unsigned char lds[];
    LAS unsigned char* const L = (LAS unsigned char*)lds;
    volatile LAS unsigned* MISC = (volatile LAS unsigned*)(L + MISC_OFF);
    const int wave0 = __builtin_amdgcn_readfirstlane(threadIdx.x >> 6);
#define LANE_SETUP() int G = gridDim.x, bx = blockIdx.x; asm volatile("" : "+s"(G), "+s"(bx)); const int vcu = (G % 8 == 0) ? (bx % 8) * (G / 8) + bx / 8 : bx; const int NGW = G * NWAVES; (void)NGW; int lane_; asm volatile("v_mbcnt_lo_u32_b32 %0, -1, 0\n\tv_mbcnt_hi_u32_b32 %0, -1, %0" : "=v"(lane_)); int wave = wave0; asm volatile("" : "+s"(wave)); const int lane = lane_, tid = wave * 64 + lane; (void)tid; const int gw = vcu * NWAVES + wave; (void)lane; (void)gw
    gu32* ctl = (gu32*)(args.ws + WS_CTL);
#define Hb ((bf16*)(GAS bf16*)(ws + WS_H))
#define SSACC(i) ((unsigned long long*)(GAS unsigned long long*)(ws + WS_SSACC) + (size_t)(i) * M)
#define SSFFA(i) ((unsigned long long*)(GAS unsigned long long*)(ws + WS_SSFFA) + (size_t)(i) * M)
#define Zb ((bf16*)(GAS bf16*)(ws + WS_Z))
#define HID ((bf16*)(GAS bf16*)(ws + WS_Z))
#define QN ((bf16*)(GAS bf16*)(ws + WS_QN))
#define KN ((bf16*)(GAS bf16*)(ws + WS_KN))
#define VN ((bf16*)(GAS bf16*)(ws + WS_VN))
#define ZT ((bf16*)(GAS bf16*)(ws + WS_ZT))
#define MB ((bf16*)(GAS bf16*)(ws + WS_ZT))
#define Fb ((bf16*)(GAS bf16*)(ws + WS_F))
#define Ob ((bf16*)(GAS bf16*)(ws + WS_O))
#define ROPE ((float*)(GAS float*)(ws + WS_ROPE))
#define DFTC ((bf16*)(GAS bf16*)(ws + WS_DFTC))
#define WBIG ((bf16*)(GAS bf16*)(ws + WS_WBIG))
#define W2P ((bf16*)(GAS bf16*)(ws + WS_W2P))
#define TWT ((float*)(GAS float*)(ws + WS_TW))
#define Y2b ((bf16*)(GAS bf16*)(ws + WS_Y2))
#define x_in (args.in[0])
#define xo   (args.out)
#define PH_SETUP() GAS unsigned char* ws = (GAS unsigned char*)args.ws; asm volatile("" : "+s"(ws)); int layer = hl >> 1; asm volatile("" : "+s"(layer)); GAS unsigned char* wl = ws + WS_W + (size_t)layer * W_LAYER; (void)wl; LANE_SETUP()
    for (int u = threadIdx.x; u < (LDS_BYTES - LDSCTL_OFF) / 4; u += NWAVES * 64) ((LAS unsigned*)(L + LDSCTL_OFF))[u] = 0u;
    __syncthreads();
    XcdBarrier bar; bar.bar = (unsigned*)(ctl + CW_BAR); bar.x = 0; bar.st = nullptr;
    if (MK_ONE_LAUNCH) bar = xcd_barrier_post((unsigned*)(ctl + CW_BAR), MISC + 8);
    const int lo = args.ph_lo, hi = args.ph_hi;
    int ph = 0;
#define IN_PH() (lo <= ph && ph < hi)
#define END_PH() do { if (MK_ONE_LAUNCH && lo <= ph && ph + 1 < hi) xcd_barrier(bar); ++ph; } while (0)

    if (IN_PH()) { {
        GAS unsigned char* ws = (GAS unsigned char*)args.ws; asm volatile("" : "+s"(ws)); LANE_SETUP();
        LAS float* scr = (LAS float*)(L + RING_OFF + wave * 16384);
        constexpr int I_G = (DM / 64) * (DFF / 32), I_D = (DFF / 64) * (DM / 32), I_IN = (DM / 64) * (DIN / 32), I_P = (DFOUR / 64) * (DM / 32), I_O = (DM / 64) * (DM / 32);
        constexpr int C1 = I_G, C2 = C1 + I_G, C3 = C2 + I_D, C4 = C3 + I_IN, C5 = C4 + I_P, C6 = C5 + I_P, C7 = C6 + I_O, C8 = C7 + I_G, C9 = C8 + I_G, C10 = C9 + I_D;
        for (int layer = 0; layer < DEPTH; ++layer) {
            GAS unsigned char* wl = ws + WS_W + (size_t)layer * W_LAYER;
            const float* gate_a = args.in[2] + (size_t)layer * DM * DFF; const float* up_a = args.in[3] + (size_t)layer * DM * DFF; const float* down_a = args.in[4] + (size_t)layer * DFF * DM;
            const float* w_in = args.in[6] + (size_t)layer * DM * DIN; const float* p_f = args.in[14] + (size_t)layer * DFOUR * DM; const float* p_a = args.in[15] + (size_t)layer * DFOUR * DM;
            const float* w_o = args.in[16] + (size_t)layer * DM * DM;
            const float* gate_b = args.in[18] + (size_t)layer * DM * DFF; const float* up_b = args.in[19] + (size_t)layer * DM * DFF; const float* down_b = args.in[20] + (size_t)layer * DFF * DM;
            for (int it = gw; it < C10; it += NGW) {
                if (it < C1)      transpose_item(gate_a, DM, DFF, (bf16*)(wl + WL_GUA), 1, scr, it, lane, args.in[1] + (size_t)layer * DM);
                else if (it < C2) transpose_item(up_a, DM, DFF, (bf16*)(wl + WL_GUA), 2, scr, it - C1, lane, args.in[1] + (size_t)layer * DM);
                else if (it < C3) transpose_item(down_a, DFF, DM, (bf16*)(wl + WL_DA), 0, scr, it - C2, lane);
                else if (it < C4) transpose_item(w_in, DM, DIN, (bf16*)(wl + WL_IN), 3, scr, it - C3, lane, args.in[5] + (size_t)layer * DM);
                else if (it < C5) transpose_item(p_f, DFOUR, DM, (bf16*)(wl + WL_PF), 0, scr, it - C4, lane);
                else if (it < C6) transpose_item(p_a, DFOUR, DM, (bf16*)(wl + WL_PA), 0, scr, it - C5, lane);
                else if (it < C7) transpose_item(w_o, DM, DM, (bf16*)(wl + WL_WO), 0, scr, it - C6, lane);
                else if (it < C8) transpose_item(gate_b, DM, DFF, (bf16*)(wl + WL_GUB), 1, scr, it - C7, lane, args.in[17] + (size_t)layer * DM);
                else if (it < C9) transpose_item(up_b, DM, DFF, (bf16*)(wl + WL_GUB), 2, scr, it - C8, lane, args.in[17] + (size_t)layer * DM);
                else              transpose_item(down_b, DFF, DM, (bf16*)(wl + WL_DB), 0, scr, it - C9, lane);
            }
        }
        const int gt = (vcu * NWAVES + wave) * 64 + lane, NGT = NGW * 64;
        for (int i = gt; i < 256 * 256; i += NGT) { const int r = i >> 8, c = i & 255, pr = r >> 7, s1p = r & 127, pc = c >> 7, s1 = c & 127, j = (s1 * s1p) & 127;
            float sn, cs; sincospif((float)j * (1.0f / 64.0f), &sn, &cs); WBIG[i] = (bf16)f2bf(pr == pc ? cs : (pr ? sn : -sn)); }
        for (int i = gt; i < 256 * 128; i += NGT) { const int r = i >> 7, c = i & 127, pc = c >> 6, s2 = c & 63, j = (s2 * r) & 63;
            float sn, cs; sincospif((float)j * (1.0f / 32.0f), &sn, &cs); W2P[i] = (bf16)f2bf(r < 64 ? (pc ? -sn : cs) : 0.0f); }
        for (int i = gt; i < 128 * 64; i += NGT) { const int s1p = i >> 6, s2 = i & 63; float sn, cs; sincospif((float)(s1p * s2) * (1.0f / 4096.0f), &sn, &cs); TWT[2 * i] = cs; TWT[2 * i + 1] = sn; }
        for (int i = gt; i < 512 * 256; i += NGT) { const int r = i >> 8, c = i & 255, part = r >> 8, cp = r & 255, j = (c * cp) & 255;
            float sn, cs; sincospif((float)j * (1.0f / 128.0f), &sn, &cs); DFTC[i] = (bf16)f2bf((part ? sn : cs) * 0.0625f); }
        for (int i = gt; i < SEQ * 8; i += NGT) { const int s = i >> 3, j = i & 7;
            const double inv = j == 0 ? 1.0 : j == 1 ? 0.19392274474868576 : j == 2 ? 0.03760603093086393 : j == 3 ? 0.007292664737217109 : j == 4 ? 0.001414213562373095 : j == 5 ? 0.0002742481756762073 : j == 6 ? 5.318295896944988e-05 : 1.031338537721246e-05;
            const double rev = (double)s * inv * 0.15915494309189535;
            const float fr = (float)(rev - __builtin_rint(rev)); float sn, cs; sincospif(2.0f * fr, &sn, &cs);
            ROPE[s * 16 + j] = cs; ROPE[s * 16 + 8 + j] = sn; }
        for (int m = gw; m < M; m += NGW) { const float ssq = row_to_bf16_ss(x_in + (size_t)m * DM, Hb + (size_t)m * DM, lane); if (lane == 0) SSFFA(0)[m] = (unsigned long long)(ssq * SS_FIX + 0.5f); }
    } }
    END_PH();

    for (int hl = 0; hl < 2 * DEPTH; ++hl) {
        const int ff = hl & 1;
        if (IN_PH()) { PH_SETUP();
            pg8::Prob g = pg8::mk_prob(Hb, (const char*)(wl + (ff ? WL_GUB : WL_GUA)), DM * 2, DM * 2, 0, 0, DM);
            pg8::GridOrder S; S.init(M / 256, 2 * DFF / 256, 1, G, bx);
            pg8::EpiSwiglu E{HID, DFF, ff ? SSACC(2 * layer + 1) : SSFFA(layer)};
            pg8::gemm_phase<pg8::EpiSwiglu, pg8::GridOrder, true, true>(L + RING_OFF, g, S, E, tid);
        }
        END_PH();
        if (IN_PH()) { PH_SETUP();
            pg8::Prob g = pg8::mk_prob(HID, (const char*)(wl + (ff ? WL_DB : WL_DA)), DFF * 2, DFF * 2, 0, 0, DFF);
            pg8::GridOrder S; S.init(M / 256, DM / 256, 1, G, bx, 4);
            if (ff == 0) {
                EpiResid<1> E{&args, hl == 0, (unsigned)(WS_SSACC + (size_t)(2 * layer) * M * 8)};
                pg8::gemm_phase<EpiResid<1>, pg8::GridOrder, true, true>(L + RING_OFF, g, S, E, tid);
            } else {
                pg8::EpiBf16 E{Y2b, DM, 1.0f, 0, nullptr};
                pg8::gemm_phase<pg8::EpiBf16, pg8::GridOrder, true, true>(L + RING_OFF, g, S, E, tid);
            }
        }
        END_PH();
        if (ff == 0) {
            if (IN_PH()) { PH_SETUP();
                pg8::Prob g = pg8::mk_prob(Hb, (const char*)(wl + WL_IN), DM * 2, DM * 2, 0, 0, DM);
                pg8::GridOrder S; S.init(M / 256, DIN / 256, 1, G, bx);
                EpiWin E{&args, SSACC(2 * layer), args.in[7] + (size_t)layer * QKD, args.in[8] + (size_t)layer * QKD};
                pg8::gemm_phase<EpiWin, pg8::GridOrder, true, true>(L + RING_OFF, g, S, E, tid);
            }
            END_PH();
            if (IN_PH()) { PH_SETUP();
                pg8::Prob g = pg8::mk_prob(DFTC, (Zb + ZC_UF), 256 * 2, 64 * DIN * 2, 0, 256 * 2, 256);
                g.hsB = DIN * 2; g.m0 = 31u; g.s0 = (size_t)2 * DIN * 2; g.sh1 = 5; g.m1 = 1u; g.s1 = (size_t)SEQ * DIN * 2; g.sh2 = 31; g.s2 = 0;
                pg8::GridOrder S; S.init(2, M / 256, 4, G, bx);
                pg8::EpiCstep E{ZT};
                pg8::gemm_phase<pg8::EpiCstep, pg8::GridOrder, true>(L + RING_OFF, g, S, E, tid);
            }
            END_PH();
            if (IN_PH()) { PH_SETUP();
                pg8::Prob g = pg8::mk_prob(WBIG, ZT, 256 * 2, 256 * 2, 0, 0, 256);
                pg8::GridOrder S; S.init(1, (1024 * 2 * 64) / 256, 1, G, bx);
                pg8::EpiS1 E{Y2b, TWT};
                pg8::gemm_phase<pg8::EpiS1, pg8::GridOrder, true>(L + RING_OFF, g, S, E, tid);
            }
            END_PH();
            if (IN_PH()) { PH_SETUP();
                float lam, negshift;
                { const float a = args.in[9][layer * QKD + lane] * args.in[10][layer * QKD + lane], b = args.in[11][layer * QKD + lane] * args.in[12][layer * QKD + lane];
                  const float lam_init = 0.8f - 0.6f * expf(-0.3f * (float)layer);
                  lam = expf(wave_sum(a)) - expf(wave_sum(b)) + lam_init; lam = __builtin_bit_cast(float, __builtin_amdgcn_readfirstlane(__builtin_bit_cast(int, lam)));
                  const float mq = wave_max(fabsf(args.in[7][layer * QKD + lane])), mk = wave_max(fabsf(args.in[8][layer * QKD + lane]));
                  const float bound = 8.0f * 1.4426950408889634f * mq * mk;
                  negshift = -fminf(bound, 60.0f); negshift = __builtin_bit_cast(float, __builtin_amdgcn_readfirstlane(__builtin_bit_cast(int, negshift))); }
                const bool noshift = negshift > -60.0f;
                const float lam_init = __builtin_bit_cast(float, __builtin_amdgcn_readfirstlane(__builtin_bit_cast(int, 0.8f - 0.6f * expf(-0.3f * (float)layer))));
                const float* gsub = args.in[13] + (size_t)layer * VD;
                for (int i = 0; i < 4; ++i) {
                    if (G != 256) break;
                    const int bh = (vcu >> 5) + 8 * (i >> 1), qb = (i & 1) * 32 + (vcu & 31), b = bh >> 3, h = bh & 7;
                    const size_t row0 = (size_t)b * SEQ, hb = (size_t)bh * SEQ * 128;
                    if (noshift) att::attn_unit<false>(QN + hb + (size_t)qb * 128 * 128, KN + hb, VN + hb, Ob + (row0 + qb * 128) * 1024 + h * 128,
                                   SEQ, negshift, lam, gsub, 1.0f - lam_init, EPS, (att::lptr)(L + RING_OFF), wave);
                    else         att::attn_unit<true>(QN + hb + (size_t)qb * 128 * 128, KN + hb, VN + hb, Ob + (row0 + qb * 128) * 1024 + h * 128,
                                   SEQ, negshift, lam, gsub, 1.0f - lam_init, EPS, (att::lptr)(L + RING_OFF), wave);
                }
                pg8::Prob g = pg8::mk_prob(W2P, Y2b, 128 * 2, 2 * 128 * 2, 0, 0, 128);
                g.m0 = 3u; g.s0 = (size_t)256 * 512; g.sh1 = 2; g.m1 = 127u; g.s1 = (size_t)1024 * 512; g.sh2 = 9; g.s2 = 256;
                pg8::GridOrder S; S.init(1, BATCH * 128 * 4, 1, G, bx);
                pg8::EpiS2 E{Fb, 0.011048543456039806f};
                int lane_b; asm volatile("v_mbcnt_lo_u32_b32 %0, -1, 0\n\tv_mbcnt_hi_u32_b32 %0, -1, %0" : "=v"(lane_b));
                pg8::gemm_phase<pg8::EpiS2, pg8::GridOrder, true>(L + RING_OFF, g, S, E, wave * 64 + lane_b);
            }
            END_PH();
            if (IN_PH()) { PH_SETUP();
                pg8::Prob g = pg8::mk_prob(Fb, (const char*)(wl + WL_PF), DFOUR * 2, DFOUR * 2, (size_t)(WS_O - WS_F), (size_t)(WL_PA - WL_PF), DFOUR);
                pg8::GridOrder S; S.init(M / 256, DM / 256, 1, G, bx, pg8::WGM, 2);
                pg8::EpiGate2 E{Zb + ZC_GF, Zb + ZC_GA, DIN, MB, DM};
                pg8::gemm_phase<pg8::EpiGate2, pg8::GridOrder, true>(L + RING_OFF, g, S, E, tid);
            }
            END_PH();
            if (IN_PH()) { PH_SETUP();
                pg8::Prob g = pg8::mk_prob(MB, (const char*)(wl + WL_WO), DM * 2, DM * 2, 0, 0, DM);
                pg8::GridOrder S; S.init(M / 256, DM / 256, 1, G, bx);
                EpiResid<2> E{&args, 0, (unsigned)(WS_SSACC + (size_t)(2 * layer + 1) * M * 8)};
                pg8::gemm_phase<EpiResid<2>, pg8::GridOrder, true, true>(L + RING_OFF, g, S, E, tid);
            }
            END_PH();
        } else {
            if (IN_PH()) { PH_SETUP();
                f32x4 go[8];
                const bool has_next = (layer + 1 < DEPTH);
#pragma unroll
                for (int j = 0; j < 8; ++j) go[j] = *((const GAS f32x4*)(args.in[21] + (size_t)layer * DM) + lane + 64 * j);
                for (int m = gw; m < M; m += NGW) {
                    GAS unsigned long long* xr = (GAS unsigned long long*)(Hb + (size_t)m * DM) + lane;
                    f32x4 v[8]; float s = 0.f;
#pragma unroll
                    for (int j = 0; j < 8; ++j) { const unsigned long long xw = xr[64 * j], yw = ((const GAS unsigned long long*)(Y2b + (size_t)m * DM) + lane)[64 * j];
                        v[j] = (f32x4){pg8::bf_lo((unsigned)xw), pg8::bf_hi((unsigned)xw), pg8::bf_lo((unsigned)(xw >> 32)), pg8::bf_hi((unsigned)(xw >> 32))}
                             + 0.5f * (f32x4){pg8::bf_lo((unsigned)yw), pg8::bf_hi((unsigned)yw), pg8::bf_lo((unsigned)(yw >> 32)), pg8::bf_hi((unsigned)(yw >> 32))};
                        s += (v[j].x * v[j].x + v[j].y * v[j].y) + (v[j].z * v[j].z + v[j].w * v[j].w); }
                    const float rstd = 1.f / sqrtf(wave_sum(s) * (1.f / DM) + EPS);
                    float s2 = 0.f;
#pragma unroll
                    for (int j = 0; j < 8; ++j) { v[j] = v[j] * rstd * go[j]; s2 += (v[j].x * v[j].x + v[j].y * v[j].y) + (v[j].z * v[j].z + v[j].w * v[j].w); }
                    if (has_next) {
                        const float ss2 = wave_sum(s2);
#pragma unroll
                        for (int j = 0; j < 8; ++j) xr[64 * j] = (unsigned long long)pk2(v[j].x, v[j].y) | ((unsigned long long)pk2(v[j].z, v[j].w) << 32);
                        if (lane == 0) SSFFA(layer + 1)[m] = (unsigned long long)(ss2 * SS_FIX + 0.5f);
                    } else {
                        GAS f32x4* orow = (GAS f32x4*)(xo + (size_t)m * DM) + lane;
#pragma unroll
                        for (int j = 0; j < 8; ++j) orow[64 * j] = v[j];
                    }
                }
            }
            END_PH();
        }
    }
#undef IN_PH
#undef END_PH
}

constexpr int N_PHASES = 1 + DEPTH * (2 + 6 + 2 + 1);

extern "C" void kernel_launch(void* const* d_in, const int* in_sizes, int n_in, void* d_out, int out_size, void* d_ws, size_t ws_size, hipStream_t stream) {
    static int grid = 0;
    if (grid == 0) {
        if (n_in != 22 || in_sizes[0] != M * DM || out_size != M * DM || ws_size < WS_END) {
            fprintf(stderr, "kernel_launch: shape/workspace mismatch: n_in %d in0 %d out %d ws %zu (need %zu); nothing launched\n", n_in, n_in > 0 ? in_sizes[0] : -1, out_size, ws_size, (size_t)WS_END); grid = -1; return; }
        int dev = 0, cus = 0;
        if (hipGetDevice(&dev) != hipSuccess || hipDeviceGetAttribute(&cus, hipDeviceAttributeMultiprocessorCount, dev) != hipSuccess) { fprintf(stderr, "kernel_launch: device query failed\n"); grid = -1; return; }
        if (hipFuncSetAttribute((const void*)enc_fwd, hipFuncAttributeMaxDynamicSharedMemorySize, LDS_BYTES) != hipSuccess) { fprintf(stderr, "kernel_launch: hipFuncSetAttribute failed\n"); grid = -1; return; }
        int per_cu = 0;
        if (hipOccupancyMaxActiveBlocksPerMultiprocessor(&per_cu, (const void*)enc_fwd, NWAVES * 64, LDS_BYTES) != hipSuccess || per_cu < 1)
            fprintf(stderr, "kernel_launch: note: occupancy query reports %d workgroups per CU\n", per_cu);
        (void)hipGetLastError();
        grid = cus;
        if (grid != 256) fprintf(stderr, "kernel_launch: %d CUs; the attention phase assumes 256\n", grid);
    }
    if (grid < 0) return;
    if (hipMemsetAsync((char*)d_ws + WS_CTL, 0, CTL_ZERO_BYTES, stream) != hipSuccess) { fprintf(stderr, "kernel_launch: memset failed\n"); return; }
    Args a{};
    for (int i = 0; i < 22; ++i) a.in[i] = (const float*)d_in[i];
    a.out = (float*)d_out; a.ws = (unsigned char*)d_ws;
#if MK_ONE_LAUNCH
    a.ph_lo = 0; a.ph_hi = N_PHASES;
    hipLaunchKernelGGL(enc_fwd, dim3(grid), dim3(NWAVES * 64), LDS_BYTES, stream, a);
#else
    for (int p = 0; p < N_PHASES; ++p) { a.ph_lo = p; a.ph_hi = p + 1; hipLaunchKernelGGL(enc_fwd, dim3(grid), dim3(NWAVES * 64), LDS_BYTES, stream, a); }
#endif
    const hipError_t le = hipPeekAtLastError();
    if (le != hipSuccess) fprintf(stderr, "kernel_launch: launch failed: %s\n", hipGetErrorName(le));
}
```

```cpp
#include <hip/hip_runtime.h>
#include <cstdio>
#include <cstdint>

#ifndef MK_ONE_LAUNCH
#define MK_ONE_LAUNCH 1
#endif

namespace pg8 {
#define PG8_LAS __attribute__((address_space(3)))
typedef unsigned short bf16_t;
typedef short bf16x8 __attribute__((ext_vector_type(8)));
typedef float f32x4 __attribute__((ext_vector_type(4)));
typedef float f32x2 __attribute__((ext_vector_type(2)));
typedef unsigned u32x4 __attribute__((ext_vector_type(4)));
constexpr int BM = 256, BK = 64, HALF = 128, HTB = HALF * BK * 2, STAGE_BYTES = 8 * HTB, NXCD = 8, WGM = 8;

__host__ __device__ __forceinline__ int lds_byte(int r, int c) { const int st = (r >> 4) * 2 + (c >> 5), rr = r & 15, cc = c & 31, ob = rr * 64 + cc * 2; return st * 1024 + (ob ^ (((ob >> 9) & 1) << 5)); }
__host__ __device__ __forceinline__ void stage_rc(int b, int& R, int& C) { const int st = b / 1024, sb = b % 1024, swz = sb ^ (((sb >> 9) & 1) << 5); R = (st >> 1) * 16 + swz / 64; C = (st & 1) * 32 + (swz % 64) / 2; }
__host__ __device__ __forceinline__ int perm32(int rho) { const int n = rho >> 4, i = rho & 15; return 8 * (i >> 2) + 4 * n + (i & 3); }

struct Unit { int pm, pn, pz; };
struct Prob { const char* A; const char* B; unsigned lda, ldb; size_t sAz, sBz; int K;
              unsigned hsB; int sh1, sh2; unsigned m0, m1; size_t s0, s1, s2;
    __device__ __forceinline__ const char* bbase(const Unit& u) const { return B + (size_t)u.pz * sBz + (size_t)((unsigned)u.pn & m0) * s0 + (size_t)(((unsigned)u.pn >> sh1) & m1) * s1 + (size_t)((unsigned)u.pn >> sh2) * s2; } };
__device__ __forceinline__ Prob mk_prob(const void* A, const void* B, unsigned lda, unsigned ldb, size_t sAz, size_t sBz, int K) {
    Prob p; p.A = (const char*)A; p.B = (const char*)B; p.lda = lda; p.ldb = ldb; p.sAz = sAz; p.sBz = sBz; p.K = K; p.hsB = HALF * ldb; p.sh1 = 0; p.sh2 = 31; p.m0 = 0x7fffffffu; p.m1 = 0u; p.s0 = (size_t)BM * ldb; p.s1 = 0; p.s2 = 0; return p; }

struct GridOrder {
    int nM, nN, nZ, nwg, G, c, wgm, seg;
    __device__ void init(int nM_, int nN_, int nZ_, int G_, int c_, int wgm_ = WGM, int seg_ = 1) { nM = nM_; nN = nN_; nZ = nZ_; nwg = nM * nN; G = G_; c = c_; wgm = wgm_; seg = seg_; }
    __device__ bool next(int i, Unit& u) const {
        const long L = (seg == 2) ? (long)(i >> 1) * G + c : (long)i * G + c; if (L >= (long)nwg * nZ) return false;
        u.pz = (seg == 2) ? (i & 1) : (int)(L / nwg);
        int wgid = (int)(L % nwg); { const int q = nwg / NXCD, r = nwg % NXCD, xcd = wgid % NXCD, off = wgid / NXCD; wgid = (xcd < r ? xcd * (q + 1) : r * (q + 1) + (xcd - r) * q) + off; }
        const int nig = wgm * nN, gid = wgid / nig, fm = gid * wgm, gsz = (nM - fm) < wgm ? (nM - fm) : wgm;
        u.pm = fm + ((wgid % nig) % gsz); u.pn = (wgid % nig) / gsz; return true;
    }
};

typedef __bf16 cv_bf16x2 __attribute__((ext_vector_type(2)));
typedef float cv_f32x2 __attribute__((ext_vector_type(2)));
__device__ __forceinline__ unsigned cvt_pk_bf16(float lo, float hi) { const cv_f32x2 v = {lo, hi}; return __builtin_bit_cast(unsigned, __builtin_convertvector(v, cv_bf16x2)); }
__device__ __forceinline__ float bf_lo(unsigned w) { return __uint_as_float(w << 16); }
__device__ __forceinline__ float bf_hi(unsigned w) { return __uint_as_float(w & 0xffff0000u); }
__device__ __forceinline__ float sigmoidf_(float x) { return __builtin_amdgcn_rcpf(1.0f + __builtin_amdgcn_exp2f(-1.4426950408889634f * x)); }

#define EPI_ROWS_BEGIN _Pragma("unroll") for (int ai = 0; ai < 2; ++ai) _Pragma("unroll") for (int m = 0; m < 4; ++m) { const int row = u.pm * BM + ai * HALF + wr * 64 + m * 16 + fr;
#define EPI_ROWS_END }

struct EpiBf16 {
    struct State { float rs[8]; };
    bf16_t* O; int ldc; float scale; int zrows; const unsigned long long* ss;
    __device__ __forceinline__ void init(f32x4 (&acc)[2][2][4][2], State& st, const Unit& u, int wr, int, int fr, int) const {
        if (ss) {
#pragma unroll
            for (int ai = 0; ai < 2; ++ai)
#pragma unroll
                for (int m = 0; m < 4; ++m) st.rs[ai * 4 + m] = __builtin_amdgcn_rsqf((float)ss[u.pm * BM + ai * HALF + wr * 64 + m * 16 + fr] * (1.0f / (1048576.0f * 2048.0f)) + 1e-6f); }

#pragma unroll
        for (int a = 0; a < 2; ++a)
#pragma unroll
            for (int b = 0; b < 2; ++b)
#pragma unroll
                for (int m = 0; m < 4; ++m)
#pragma unroll
                    for (int n = 0; n < 2; ++n) acc[a][b][m][n] = (f32x4){0.f, 0.f, 0.f, 0.f}; }
    __device__ __forceinline__ void operator()(const f32x4 (&acc)[2][2][4][2], const State& st, const Unit& u, int wr, int wc, int fr, int fq) const {
        const int col0 = u.pn * BM + wc * 32 + 8 * fq;
        EPI_ROWS_BEGIN
            bf16_t* rowp = O + (size_t)(u.pz * zrows + row) * ldc + col0;
            const float rs = ss ? scale * st.rs[ai * 4 + m] : scale;
#pragma unroll
            for (int bj = 0; bj < 2; ++bj) { const f32x4 v0 = acc[ai][bj][m][0] * rs, v1 = acc[ai][bj][m][1] * rs;
                u32x4 w; w.x = cvt_pk_bf16(v0[0], v0[1]); w.y = cvt_pk_bf16(v0[2], v0[3]); w.z = cvt_pk_bf16(v1[0], v1[1]); w.w = cvt_pk_bf16(v1[2], v1[3]);
                *(u32x4*)(rowp + bj * HALF) = w; }
        EPI_ROWS_END
    }
};
struct EpiSwiglu {
    struct State { float rs[8]; };
    bf16_t* O; int ldc; const unsigned long long* ss;
    __device__ __forceinline__ void init(f32x4 (&acc)[2][2][4][2], State& st, const Unit& u, int wr, int, int fr, int) const {
        {
#pragma unroll
            for (int ai = 0; ai < 2; ++ai)
#pragma unroll
                for (int m = 0; m < 4; ++m) st.rs[ai * 4 + m] = __builtin_amdgcn_rsqf((float)ss[u.pm * BM + ai * HALF + wr * 64 + m * 16 + fr] * (1.0f / (1048576.0f * 2048.0f)) + 1e-6f); }

#pragma unroll
        for (int a = 0; a < 2; ++a)
#pragma unroll
            for (int b = 0; b < 2; ++b)
#pragma unroll
                for (int m = 0; m < 4; ++m)
#pragma unroll
                    for (int n = 0; n < 2; ++n) acc[a][b][m][n] = (f32x4){0.f, 0.f, 0.f, 0.f}; }
    __device__ __forceinline__ void operator()(const f32x4 (&acc)[2][2][4][2], const State& st, const Unit& u, int wr, int wc, int fr, int fq) const {
        const int col0 = u.pn * HALF + wc * 32 + 8 * fq;
        EPI_ROWS_BEGIN
            const float rs = st.rs[ai * 4 + m];
            float h[8];
#pragma unroll
            for (int n = 0; n < 2; ++n)
#pragma unroll
                for (int e = 0; e < 4; ++e) { const float g = acc[ai][0][m][n][e] * rs, up = acc[ai][1][m][n][e] * rs; h[n * 4 + e] = g * sigmoidf_(g) * up; }
            u32x4 w; w.x = cvt_pk_bf16(h[0], h[1]); w.y = cvt_pk_bf16(h[2], h[3]); w.z = cvt_pk_bf16(h[4], h[5]); w.w = cvt_pk_bf16(h[6], h[7]);
            *(u32x4*)(O + (size_t)row * ldc + col0) = w;
        EPI_ROWS_END
    }
};
struct EpiGate {
    struct State { float rs[8]; };
    const bf16_t* G; int ldg; const bf16_t* T; bf16_t* O; int ldc; int add;
    __device__ __forceinline__ void init(f32x4 (&acc)[2][2][4][2], State&, const Unit&, int, int, int, int) const {
#pragma unroll
        for (int a = 0; a < 2; ++a)
#pragma unroll
            for (int b = 0; b < 2; ++b)
#pragma unroll
                for (int m = 0; m < 4; ++m)
#pragma unroll
                    for (int n = 0; n < 2; ++n) acc[a][b][m][n] = (f32x4){0.f, 0.f, 0.f, 0.f}; }
    __device__ __forceinline__ void operator()(const f32x4 (&acc)[2][2][4][2], const State& st, const Unit& u, int wr, int wc, int fr, int fq) const {
        const int col0 = u.pn * BM + wc * 32 + 8 * fq;
        EPI_ROWS_BEGIN
#pragma unroll
            for (int bj = 0; bj < 2; ++bj) {
                const u32x4 gw = *(const u32x4*)(G + (size_t)row * ldg + col0 + bj * HALF);
                u32x4 tw = (u32x4){0u, 0u, 0u, 0u};
                if (add) tw = *(const u32x4*)(T + (size_t)row * ldc + col0 + bj * HALF);
                float r[8];
#pragma unroll
                for (int q = 0; q < 4; ++q) {
                    const float a0 = acc[ai][bj][m][q >> 1][(q & 1) * 2], a1 = acc[ai][bj][m][q >> 1][(q & 1) * 2 + 1];
                    r[2 * q] = bf_lo(tw[q]) + sigmoidf_(bf_lo(gw[q])) * a0; r[2 * q + 1] = bf_hi(tw[q]) + sigmoidf_(bf_hi(gw[q])) * a1; }
                u32x4 w; w.x = cvt_pk_bf16(r[0], r[1]); w.y = cvt_pk_bf16(r[2], r[3]); w.z = cvt_pk_bf16(r[4], r[5]); w.w = cvt_pk_bf16(r[6], r[7]);
                *(u32x4*)(O + (size_t)row * ldc + col0 + bj * HALF) = w; }
        EPI_ROWS_END
    }
};
struct EpiGate2 {
    struct State { float rs[8]; };
    const bf16_t* Gf; const bf16_t* Ga; int ldg; bf16_t* O; int ldc;
    __device__ __forceinline__ void init(f32x4 (&acc)[2][2][4][2], State&, const Unit& u, int, int, int, int) const {
        if (u.pz != 0) return;
#pragma unroll
        for (int a = 0; a < 2; ++a)
#pragma unroll
            for (int b = 0; b < 2; ++b)
#pragma unroll
                for (int m = 0; m < 4; ++m)
#pragma unroll
                    for (int n = 0; n < 2; ++n) acc[a][b][m][n] = (f32x4){0.f, 0.f, 0.f, 0.f}; }
    __device__ __forceinline__ void operator()(f32x4 (&acc)[2][2][4][2], const State& st, const Unit& u, int wr, int wc, int fr, int fq) const {
        const int col0 = u.pn * BM + wc * 32 + 8 * fq;
        EPI_ROWS_BEGIN
#pragma unroll
            for (int bj = 0; bj < 2; ++bj) {
                const u32x4 ga = *(const u32x4*)(Ga + (size_t)row * ldg + col0 + bj * HALF);
                if (u.pz == 0) {
                    const u32x4 gf = *(const u32x4*)(Gf + (size_t)row * ldg + col0 + bj * HALF);
#pragma unroll
                    for (int q = 0; q < 4; ++q) {
                        const float e0 = __builtin_amdgcn_exp2f(-1.4426950408889634f * bf_lo(ga[q])), e1 = __builtin_amdgcn_exp2f(-1.4426950408889634f * bf_hi(ga[q]));
                        const float f0 = __builtin_amdgcn_exp2f(-1.4426950408889634f * bf_lo(gf[q])), f1 = __builtin_amdgcn_exp2f(-1.4426950408889634f * bf_hi(gf[q]));
                        acc[ai][bj][m][q >> 1][(q & 1) * 2] *= (1.0f + e0) * __builtin_amdgcn_rcpf(1.0f + f0);
                        acc[ai][bj][m][q >> 1][(q & 1) * 2 + 1] *= (1.0f + e1) * __builtin_amdgcn_rcpf(1.0f + f1); }
                } else {
                    float r[8];
#pragma unroll
                    for (int q = 0; q < 4; ++q) { r[2 * q] = sigmoidf_(bf_lo(ga[q])) * acc[ai][bj][m][q >> 1][(q & 1) * 2]; r[2 * q + 1] = sigmoidf_(bf_hi(ga[q])) * acc[ai][bj][m][q >> 1][(q & 1) * 2 + 1]; }
                    u32x4 w; w.x = cvt_pk_bf16(r[0], r[1]); w.y = cvt_pk_bf16(r[2], r[3]); w.z = cvt_pk_bf16(r[4], r[5]); w.w = cvt_pk_bf16(r[6], r[7]);
                    *(u32x4*)(O + (size_t)row * ldc + col0 + bj * HALF) = w; }
            }
        EPI_ROWS_END
    }
};
struct EpiCstep {
    struct State { float rs[8]; };
    bf16_t* X1;
    __device__ __forceinline__ void init(f32x4 (&acc)[2][2][4][2], State&, const Unit&, int, int, int, int) const {
#pragma unroll
        for (int a = 0; a < 2; ++a)
#pragma unroll
            for (int b = 0; b < 2; ++b)
#pragma unroll
                for (int m = 0; m < 4; ++m)
#pragma unroll
                    for (int n = 0; n < 2; ++n) acc[a][b][m][n] = (f32x4){0.f, 0.f, 0.f, 0.f}; }
    __device__ __forceinline__ void operator()(const f32x4 (&acc)[2][2][4][2], const State& st, const Unit& u, int wr, int wc, int fr, int fq) const {
        const int b = u.pn >> 5, s1_0 = wc * 32 + 8 * fq;
        EPI_ROWS_BEGIN
            const int gc = u.pz * 256 + (row - u.pm * BM);
#pragma unroll
            for (int bj = 0; bj < 2; ++bj) { const int s2 = 2 * (u.pn & 31) + bj;
                const f32x4 v0 = acc[ai][bj][m][0], v1 = acc[ai][bj][m][1];
                u32x4 w; w.x = cvt_pk_bf16(v0[0], v0[1]); w.y = cvt_pk_bf16(v0[2], v0[3]); w.z = cvt_pk_bf16(v1[0], v1[1]); w.w = cvt_pk_bf16(v1[2], v1[3]);
                *(u32x4*)(X1 + ((size_t)((((gc * 2 + b) * 64 + s2) * 2 + u.pm) * 128) + s1_0)) = w; }
        EPI_ROWS_END
    }
};
struct EpiS1 {
    struct State { float rs[8]; };
    bf16_t* Y2; const float* TW;
    __device__ __forceinline__ void init(f32x4 (&acc)[2][2][4][2], State&, const Unit&, int, int, int, int) const {
#pragma unroll
        for (int a = 0; a < 2; ++a)
#pragma unroll
            for (int b = 0; b < 2; ++b)
#pragma unroll
                for (int m = 0; m < 4; ++m)
#pragma unroll
                    for (int n = 0; n < 2; ++n) acc[a][b][m][n] = (f32x4){0.f, 0.f, 0.f, 0.f}; }
    __device__ __forceinline__ void operator()(const f32x4 (&acc)[2][2][4][2], const State& st, const Unit& u, int wr, int wc, int fr, int fq) const {
        const int s2_0 = (wc & 1) * 32 + 8 * fq;
#pragma unroll
        for (int m = 0; m < 4; ++m) {
            const int s1p = wr * 64 + m * 16 + fr;
            const f32x4* tp = (const f32x4*)(TW + ((size_t)s1p * 64 + s2_0) * 2);
            const f32x4 t0 = tp[0], t1 = tp[1], t2 = tp[2], t3 = tp[3];
            const float tc[8] = {t0[0], t0[2], t1[0], t1[2], t2[0], t2[2], t3[0], t3[2]}, ts[8] = {t0[1], t0[3], t1[1], t1[3], t2[1], t2[3], t3[1], t3[3]};
#pragma unroll
            for (int bj = 0; bj < 2; ++bj) {
                const int q = u.pn * 4 + bj * 2 + (wc >> 1);
                float yr[8], yi[8];
#pragma unroll
                for (int e = 0; e < 8; ++e) { const float a = acc[0][bj][m][e >> 2][e & 3], c = acc[1][bj][m][e >> 2][e & 3]; yr[e] = a * tc[e] - c * ts[e]; yi[e] = a * ts[e] + c * tc[e]; }
                u32x4 w0, w1;
                w0.x = cvt_pk_bf16(yr[0], yr[1]); w0.y = cvt_pk_bf16(yr[2], yr[3]); w0.z = cvt_pk_bf16(yr[4], yr[5]); w0.w = cvt_pk_bf16(yr[6], yr[7]);
                w1.x = cvt_pk_bf16(yi[0], yi[1]); w1.y = cvt_pk_bf16(yi[2], yi[3]); w1.z = cvt_pk_bf16(yi[4], yi[5]); w1.w = cvt_pk_bf16(yi[6], yi[7]);
                bf16_t* dst = Y2 + ((size_t)(s1p * 2048 + q) * 2) * 64 + s2_0;
                *(u32x4*)dst = w0; *(u32x4*)(dst + 64) = w1; }
        }
    }
};
struct EpiS2 {
    struct State { float rs[8]; };
    bf16_t* F; float scale;
    __device__ __forceinline__ void init(f32x4 (&acc)[2][2][4][2], State&, const Unit&, int, int, int, int) const {
#pragma unroll
        for (int a = 0; a < 2; ++a)
#pragma unroll
            for (int b = 0; b < 2; ++b)
#pragma unroll
                for (int m = 0; m < 4; ++m)
#pragma unroll
                    for (int n = 0; n < 2; ++n) acc[a][b][m][n] = (f32x4){0.f, 0.f, 0.f, 0.f}; }
    __device__ __forceinline__ void operator()(const f32x4 (&acc)[2][2][4][2], const State& st, const Unit& u, int wr, int wc, int fr, int fq) const {
        if (wr != 0) return;
        const int gt = u.pn & 3, s1p = (u.pn >> 2) & 127, b = u.pn >> 9;
        const int col0 = gt * 256 + wc * 32 + 8 * fq;
#pragma unroll
        for (int m = 0; m < 4; ++m) { const int s2p = m * 16 + fr;
            bf16_t* rowp = F + (size_t)(b * 8192 + s1p + 128 * s2p) * 1024 + col0;
#pragma unroll
            for (int bj = 0; bj < 2; ++bj) { const f32x4 v0 = acc[0][bj][m][0] * scale, v1 = acc[0][bj][m][1] * scale;
                u32x4 w; w.x = cvt_pk_bf16(v0[0], v0[1]); w.y = cvt_pk_bf16(v0[2], v0[3]); w.z = cvt_pk_bf16(v1[0], v1[1]); w.w = cvt_pk_bf16(v1[2], v1[3]);
                *(u32x4*)(rowp + bj * HALF) = w; } }
    }
};

template <class Epi, class Sched, bool ALIGN_EPI, bool SNAKE = false>
__device__ __forceinline__ void gemm_phase(PG8_LAS unsigned char* lds, const Prob g, const Sched S, const Epi E, const int tid_in) {
    const int tid = tid_in, wid = __builtin_amdgcn_readfirstlane(tid >> 6), lane = tid & 63, wr = wid >> 2, wc = wid & 3, fr = lane & 15, fq = lane >> 4;
    int K = g.K; asm volatile("" : "+s"(K)); const int nt = K / BK;
    unsigned voffA[2], voffB[2];
#pragma unroll
    for (int i = 0; i < 2; ++i) { int R, C; stage_rc(tid * 16 + i * 8192, R, C); const int Rb = (R & ~31) + perm32(R & 31);
        voffA[i] = (unsigned)R * g.lda + (unsigned)C * 2u; voffB[i] = (unsigned)Rb * g.ldb + (unsigned)C * 2u; }
    const size_t kstep = (size_t)(BK * 2);
    const size_t hstepA = (size_t)HALF * g.lda, hstepB = (size_t)g.hsB;
    const size_t tstepA = 2 * hstepA;
    const unsigned ldsw = (unsigned)wid * 1024u;
    const int aoff = lds_byte(wr * 64 + fr, fq * 8), boff = lds_byte(wc * 32 + fr, fq * 8);
#define PG8_SA(b, h) (((b) * 2 + (h)) * HTB)
#define PG8_SB(b, h) ((4 + (b) * 2 + (h)) * HTB)
#define PG8_STAGE(bufoff, gbase, voff) do { _Pragma("unroll") for (int _i = 0; _i < 2; ++_i) \
        __builtin_amdgcn_global_load_lds((const unsigned*)((const char*)(gbase) + (voff)[_i]), (PG8_LAS unsigned*)(lds + (bufoff) + ldsw + _i * 8192), 16, 0, 0); } while (0)
#define PG8_LDA(dst, b, h) do { _Pragma("unroll") for (int m = 0; m < 4; ++m) _Pragma("unroll") for (int k = 0; k < 2; ++k) dst[m][k] = *(const PG8_LAS bf16x8*)(lds + PG8_SA(b, h) + aoff + m * 2048 + k * 1024); } while (0)
#define PG8_LDB(dst, b, h) do { _Pragma("unroll") for (int n = 0; n < 2; ++n) _Pragma("unroll") for (int k = 0; k < 2; ++k) dst[n][k] = *(const PG8_LAS bf16x8*)(lds + PG8_SB(b, h) + boff + n * 2048 + k * 1024); } while (0)
#define PG8_MMA(ai, bj, At, Bt) do { __builtin_amdgcn_s_setprio(1); _Pragma("unroll") for (int m = 0; m < 4; ++m) _Pragma("unroll") for (int n = 0; n < 2; ++n) _Pragma("unroll") for (int k = 0; k < 2; ++k) \
        acc[ai][bj][m][n] = __builtin_amdgcn_mfma_f32_16x16x32_bf16(Bt[n][k], At[m][k], acc[ai][bj][m][n], 0, 0, 0); __builtin_amdgcn_s_setprio(0); } while (0)
#define PG8_WAIT_V(n) asm volatile("s_waitcnt vmcnt(" #n ")" ::: "memory")
#define PG8_WAIT_L(n) asm volatile("s_waitcnt lgkmcnt(" #n ")" ::: "memory")
#define PG8_BAR __builtin_amdgcn_s_barrier()
#define PG8_SCHED __builtin_amdgcn_sched_barrier(0)
    Unit cur, nxt; int ui = 0;
    if (!S.next(0, cur)) return;
    f32x4 acc[2][2][4][2]; typename Epi::State est;
    E.init(acc, est, cur, wr, wc, fr, fq);
    bf16x8 At[4][2], B0[2][2], B1[2][2];
    const char* cA = g.A + (size_t)cur.pz * g.sAz + (size_t)cur.pm * tstepA; const char* cB = g.bbase(cur);
    PG8_STAGE(PG8_SB(0, 0), cB, voffB); PG8_STAGE(PG8_SB(0, 1), cB + hstepB, voffB); PG8_STAGE(PG8_SA(0, 0), cA, voffA); PG8_STAGE(PG8_SA(0, 1), cA + hstepA, voffA);
    if (wr == 1) PG8_BAR;
    PG8_WAIT_V(2); PG8_BAR;
    long ksc = (long)kstep;
    PG8_STAGE(PG8_SB(1, 0), cB + kstep, voffB); PG8_STAGE(PG8_SA(1, 0), cA + kstep, voffA); PG8_STAGE(PG8_SB(1, 1), cB + hstepB + kstep, voffB);
    PG8_WAIT_V(6); PG8_BAR;
    for (;;) {
        const bool has_next = S.next(ui + 1, nxt);
        const bool nrev = SNAKE && has_next && ((ui + 1) & 1);
        const long ksn = !has_next ? ksc : (nrev ? -(long)kstep : (long)kstep);
        const size_t noff = nrev ? (size_t)(nt - 1) * kstep : 0;
        const char* nA = has_next ? g.A + (size_t)nxt.pz * g.sAz + (size_t)nxt.pm * tstepA + noff : cA; const char* nB = has_next ? g.bbase(nxt) + noff : cB;
        for (int t = 0; t < nt; t += 2) {
            const bool last = (t == nt - 2);
            const char* a1 = cA + (long)(t + 1) * ksc;
            const char* a2 = last ? nA : cA + (long)(t + 2) * ksc; const char* b2 = last ? nB : cB + (long)(t + 2) * ksc;
            const char* a3 = a2 + (last ? ksn : ksc); const char* b3 = b2 + (last ? ksn : ksc);
            PG8_LDB(B0, 0, 0); PG8_LDB(B1, 0, 1); PG8_SCHED; PG8_LDA(At, 0, 0); PG8_STAGE(PG8_SA(1, 1), a1 + hstepA, voffA);
            PG8_WAIT_V(8); PG8_WAIT_L(0); PG8_BAR; PG8_MMA(0, 0, At, B0); PG8_MMA(0, 1, At, B1); PG8_BAR; PG8_SCHED;
            PG8_LDA(At, 0, 1); PG8_STAGE(PG8_SB(0, 0), b2, voffB); PG8_STAGE(PG8_SB(0, 1), b2 + hstepB, voffB); PG8_STAGE(PG8_SA(0, 0), a2, voffA);
            PG8_WAIT_V(8); PG8_WAIT_L(0); PG8_BAR; PG8_MMA(1, 0, At, B0); PG8_MMA(1, 1, At, B1); PG8_BAR; PG8_SCHED;
            PG8_LDB(B0, 1, 0); PG8_LDB(B1, 1, 1); PG8_SCHED; PG8_LDA(At, 1, 0); PG8_STAGE(PG8_SA(0, 1), a2 + hstepA, voffA);
            PG8_WAIT_V(8); PG8_WAIT_L(0); PG8_BAR; PG8_MMA(0, 0, At, B0); PG8_MMA(0, 1, At, B1); PG8_BAR; PG8_SCHED;
            PG8_LDA(At, 1, 1); PG8_STAGE(PG8_SB(1, 0), b3, voffB); PG8_STAGE(PG8_SB(1, 1), b3 + hstepB, voffB); PG8_STAGE(PG8_SA(1, 0), a3, voffA);
            PG8_WAIT_V(8); PG8_WAIT_L(0); PG8_BAR; PG8_MMA(1, 0, At, B0); PG8_MMA(1, 1, At, B1); PG8_BAR; PG8_SCHED;
        }
        if constexpr (ALIGN_EPI) { if (wr == 0) PG8_BAR; }
        E(acc, est, cur, wr, wc, fr, fq);
        if (!has_next) break;
        E.init(acc, est, nxt, wr, wc, fr, fq);
        cur = nxt; cA = nA; cB = nB; ksc = ksn; ++ui;
        if constexpr (ALIGN_EPI) { if (wr == 1) PG8_BAR; }
    }
    PG8_WAIT_V(0);
    if constexpr (!ALIGN_EPI) { if (wr == 0) PG8_BAR; }
    PG8_BAR;
#undef PG8_SA
#undef PG8_SB
#undef PG8_STAGE
#undef PG8_LDA
#undef PG8_LDB
#undef PG8_MMA
#undef PG8_WAIT_V
#undef PG8_WAIT_L
#undef PG8_BAR
#undef PG8_SCHED
}
}

namespace att {
typedef unsigned short bf16_t;
using bf16x8 = __attribute__((ext_vector_type(8))) short;
using s16x4  = __attribute__((ext_vector_type(4))) short;
using f32x16 = __attribute__((ext_vector_type(16))) float;
using u32x4  = __attribute__((ext_vector_type(4))) unsigned;
constexpr int NW = 8, QBLK = 32, KVBLK = 64;
constexpr int LDQ = 128, LDK = 128, LDV = 128, LDO = 1024;
#define KSWZ(row, colB) ((row) * 256 + ((colB) ^ (((row) & 7) << 4)))
#define SBAR() __builtin_amdgcn_sched_barrier(0)
template <int X> __device__ __forceinline__ float sx(float v) { return __int_as_float(__builtin_amdgcn_ds_swizzle(__float_as_int(v), 0x1f | (X << 10))); }
__device__ __forceinline__ int crow(int r, int hi) { return (r & 3) + 8 * (r >> 2) + 4 * hi; }
__device__ __forceinline__ unsigned cvtpk(float lo, float hi) { return pg8::cvt_pk_bf16(lo, hi); }
__device__ __forceinline__ int v_st(int k, int c) { const int kk = (k & ~0xC) | ((k & 4) << 1) | ((k & 8) >> 1); return ((kk >> 3) * 4 + (c >> 5)) * 512 + ((kk & 7) * 32 + (c & 31)) * 2; }
__device__ __forceinline__ int v_rd_base(int lane) { return ((lane & 3) << 3) | (((lane >> 2) & 3) << 6) | (((lane >> 4) & 1) << 5) | (((lane >> 5) & 1) << 8); }
constexpr int v_rd_off(int d0, int ks, int half) { return d0 * 512 + ks * 4096 + half * 2048; }
template <int OFF> __device__ __forceinline__ s16x4 tr_read(int vb) {
  s16x4 r; asm volatile("ds_read_b64_tr_b16 %0, %1 offset:%2" : "=&v"(r) : "v"(vb), "i"(OFF) : "memory"); return r;
}
typedef __attribute__((address_space(3))) char* lptr;
typedef short v4i16_t __attribute__((ext_vector_type(4)));
#define LDSV(T, p) (*(__attribute__((address_space(3))) T*)(p))
constexpr int KSLOT = 16640, VSLOT = 16384, NSLOT = 4, K_OFF = 0, V_OFF = NSLOT * KSLOT, WS_OFF = V_OFF + NSLOT * VSLOT;
constexpr int CH = 2080;
__device__ __forceinline__ int k_img(int key, int chunk, int h) { return chunk * CH + key * 32 + ((h ^ ((key >> 3) & 1)) * 16); }
template <int OFF> __device__ __forceinline__ bf16x8 rd128(int a) { bf16x8 r; asm volatile("ds_read_b128 %0, %1 offset:%2" : "=&v"(r) : "v"(a), "i"(OFF) : "memory"); return r; }
#define LWAIT(N) do { asm volatile("s_waitcnt lgkmcnt(" #N ")" ::: "memory"); SBAR(); } while (0)
__device__ __forceinline__ s16x4 vtr(lptr p) { return __builtin_bit_cast(s16x4, __builtin_amdgcn_ds_read_tr16_b64_v4i16((__attribute__((address_space(3))) v4i16_t*)p)); }
#define PK4(P, BASE, OUT) do { unsigned a0 = cvtpk(P[BASE + 0], P[BASE + 1]), a1 = cvtpk(P[BASE + 2], P[BASE + 3]);   \
    unsigned b0 = cvtpk(P[BASE + 4], P[BASE + 5]), b1 = cvtpk(P[BASE + 6], P[BASE + 7]);                              \
    auto r0 = __builtin_amdgcn_permlane32_swap(a0, b0, false, false); auto r1 = __builtin_amdgcn_permlane32_swap(a1, b1, false, false); \
    u32x4 w = {r0[0], r1[0], r0[1], r1[1]}; OUT = *reinterpret_cast<bf16x8*>(&w); } while (0)
template <bool SHIFT>
__device__ __forceinline__ void attn_unit(const bf16_t* __restrict__ Qb, const bf16_t* __restrict__ Kh, const bf16_t* __restrict__ Vh, bf16_t* __restrict__ Ob,
                                          int seq, float negshift, float lam, const float* __restrict__ gsub, float oscale, float eps, lptr lds, const int wave_in) {
  int lane_s; asm volatile("v_mbcnt_lo_u32_b32 %0, -1, 0\n\tv_mbcnt_hi_u32_b32 %0, -1, %0" : "=v"(lane_s));
  const int wid = wave_in, lane = lane_s, tid = wid * 64 + lane, r32 = lane & 31, hi = lane >> 5, comp = wid >> 2, wq = wid & 3;
#define UNI(x) __builtin_bit_cast(float, __builtin_amdgcn_readfirstlane(__builtin_bit_cast(int, (x))))
  lam = UNI(lam); oscale = UNI(oscale); eps = UNI(eps); negshift = UNI(negshift);
#undef UNI
  float l = 0.f; f32x16 o[4] = {}; bf16x8 qr[4];
  const bf16_t* Qw = Qb + (long)(wq * QBLK + r32) * LDQ + comp * 64 + hi * 8;
#pragma unroll
  for (int d0 = 0; d0 < 4; ++d0) qr[d0] = *reinterpret_cast<const bf16x8*>(Qw + d0 * 16);
  const int sr = tid >> 4, sc = (tid & 15) * 8;
  const lptr kwr = lds + K_OFF + k_img(sr, sc >> 4, (sc >> 3) & 1);
  const lptr vwr = lds + V_OFF + v_st(sr, sc);
  const lptr krd = lds + K_OFF + k_img(r32, comp * 4, hi);
  const lptr vrd = lds + V_OFF + v_rd_base(lane);
  unsigned voffK = (unsigned)(sr * LDK + sc) * 2u, voffV = (unsigned)(sr * LDV + sc) * 2u; asm volatile("" : "+v"(voffK), "+v"(voffV));
  const char* kg = (const char*)Kh; const char* vg = (const char*)Vh;
  bf16x8 vs0, vs1, ks0, ks1;
#define SLOAD() do { vs0 = *reinterpret_cast<const bf16x8*>(vg + voffV); vs1 = *reinterpret_cast<const bf16x8*>(vg + (size_t)32 * LDV * 2 + voffV); \
    ks0 = *reinterpret_cast<const bf16x8*>(kg + voffK); ks1 = *reinterpret_cast<const bf16x8*>(kg + (size_t)32 * LDK * 2 + voffK); kg += (size_t)KVBLK * LDK * 2; vg += (size_t)KVBLK * LDV * 2; } while (0)
#define SWRITE(sl) do { LDSV(bf16x8, vwr + (sl) * VSLOT) = vs0; LDSV(bf16x8, vwr + (sl) * VSLOT + 8192) = vs1; LDSV(bf16x8, kwr + (sl) * KSLOT) = ks0; LDSV(bf16x8, kwr + (sl) * KSLOT + 1024) = ks1; } while (0)
#define MREAD(KO, VS, H, DO_QK, DO_PV) \
    if (DO_QK) { _Pragma("unroll") for (int d0 = 0; d0 < 4; ++d0) kf[d0] = LDSV(const bf16x8, krd + (KO) + d0 * CH); } \
    if (DO_PV) { _Pragma("unroll") for (int d0 = 0; d0 < 4; ++d0) _Pragma("unroll") for (int ks = 0; ks < 2; ++ks) { \
        vl[d0][ks] = vtr(vrd + (VS) * VSLOT + v_rd_off(d0, 2 * (H) + ks, 0)); vh[d0][ks] = vtr(vrd + (VS) * VSLOT + v_rd_off(d0, 2 * (H) + ks, 1)); } }
#define MCOMP(SC, SN, PP, PC, DO_QK, DO_PV, NWR) \
    if (DO_QK) { const f32x16 z = {}; SN = __builtin_amdgcn_mfma_f32_32x32x16_bf16(kf[0], qr[0], z, 0, 0, 0); \
        _Pragma("unroll") for (int d0 = 1; d0 < 4; ++d0) SN = __builtin_amdgcn_mfma_f32_32x32x16_bf16(kf[d0], qr[d0], SN, 0, 0, 0); } \
    { _Pragma("unroll") for (int r = 0; r < 16; ++r) SC[r] = __builtin_amdgcn_exp2f(SHIFT ? SC[r] + negshift : SC[r]); \
      float ps = 0.f; _Pragma("unroll") for (int r = 0; r < 16; ++r) ps += SC[r]; l += ps; \
      PK4(SC, 0, PC[0]); PK4(SC, 8, PC[1]); } \
    if (DO_PV) { _Pragma("unroll") for (int d0 = 0; d0 < 4; ++d0) _Pragma("unroll") for (int ks = 0; ks < 2; ++ks) { \
        const bf16x8 vf = (bf16x8){vl[d0][ks][0], vl[d0][ks][1], vl[d0][ks][2], vl[d0][ks][3], vh[d0][ks][0], vh[d0][ks][1], vh[d0][ks][2], vh[d0][ks][3]}; \
        o[d0] = __builtin_amdgcn_mfma_f32_32x32x16_bf16(PP[ks], vf, o[d0], 0, 0, 0); } } \
      \
      \
    __builtin_amdgcn_sched_group_barrier(0x100, 20, 0); if (NWR) __builtin_amdgcn_sched_group_barrier(0x200, NWR, 0); if (SHIFT) __builtin_amdgcn_sched_group_barrier(0x002, 16, 0); \
    _Pragma("unroll") for (int i_ = 0; i_ < 8; ++i_) { __builtin_amdgcn_sched_group_barrier(0x008, 1, 0); __builtin_amdgcn_sched_group_barrier(0x400, 2, 0); __builtin_amdgcn_sched_group_barrier(0x002, 2, 0); } \
    _Pragma("unroll") for (int i_ = 0; i_ < 4; ++i_) { __builtin_amdgcn_sched_group_barrier(0x008, 1, 0); __builtin_amdgcn_sched_group_barrier(0x002, 3, 0); } \
    SBAR();
#define STEP(TM, DO_PREV, DO_NEXT, DO_WR, DO_LD) do { \
    __syncthreads(); \
    { bf16x8 kf[4]; s16x4 vl[4][2], vh[4][2]; MREAD((TM) * KSLOT + 1024, ((TM) + 3) & 3, 1, true, DO_PREV) MCOMP(sA, sB, pY, pX, true, DO_PREV, 0) } \
    { bf16x8 kf[4]; s16x4 vl[4][2], vh[4][2]; MREAD((((TM) + 1) & 3) * KSLOT, TM, 0, DO_NEXT, true) \
      if (DO_WR) SWRITE(((TM) + 2) & 3); \
      if (DO_LD) SLOAD(); \
      MCOMP(sB, sA, pX, pY, DO_NEXT, true, (DO_WR) ? 4 : 0) } } while (0)
  const int NT = seq / KVBLK;
  f32x16 sA, sB; bf16x8 pX[2], pY[2];
  if (comp == 1) __builtin_amdgcn_s_setprio(1);
  SLOAD(); SWRITE(0); SLOAD(); SWRITE(1); SLOAD();
  __syncthreads();
  { const f32x16 z = {}; sA = __builtin_amdgcn_mfma_f32_32x32x16_bf16(LDSV(const bf16x8, krd), qr[0], z, 0, 0, 0);
#pragma unroll
    for (int d0 = 1; d0 < 4; ++d0) sA = __builtin_amdgcn_mfma_f32_32x32x16_bf16(LDSV(const bf16x8, krd + d0 * CH), qr[d0], sA, 0, 0, 0); }
  STEP(0, false, true, true, true);
  STEP(1, true, true, true, true); STEP(2, true, true, true, true); STEP(3, true, true, true, true);
  for (int t = 4; t + 4 < NT; t += 4) {
    STEP(0, true, true, true, true); STEP(1, true, true, true, true); STEP(2, true, true, true, true); STEP(3, true, true, true, true);
  }
  STEP(0, true, true, true, true);
  STEP(1, true, true, true, false);
  STEP(2, true, true, false, false);
  STEP(3, true, false, false, false);
  { s16x4 vl[4][2], vh[4][2];
#pragma unroll
    for (int d0 = 0; d0 < 4; ++d0)
#pragma unroll
      for (int ks = 0; ks < 2; ++ks) { vl[d0][ks] = vtr(vrd + 3 * VSLOT + v_rd_off(d0, 2 + ks, 0)); vh[d0][ks] = vtr(vrd + 3 * VSLOT + v_rd_off(d0, 2 + ks, 1)); }
#pragma unroll
    for (int d0 = 0; d0 < 4; ++d0)
#pragma unroll
      for (int ks = 0; ks < 2; ++ks) { const bf16x8 vf = (bf16x8){vl[d0][ks][0], vl[d0][ks][1], vl[d0][ks][2], vl[d0][ks][3], vh[d0][ks][0], vh[d0][ks][1], vh[d0][ks][2], vh[d0][ks][3]};
        o[d0] = __builtin_amdgcn_mfma_f32_32x32x16_bf16(pY[ks], vf, o[d0], 0, 0, 0); } }
  __builtin_amdgcn_s_setprio(0);
#undef MREAD
#undef MCOMP
#undef SLOAD
#undef SWRITE
#undef STEP
  { auto rr = __builtin_amdgcn_permlane32_swap(__float_as_uint(l), __float_as_uint(l), false, false); l = __uint_as_float(rr[0]) + __uint_as_float(rr[1]); }
  int lane_e; asm volatile("v_mbcnt_lo_u32_b32 %0, -1, 0\n\tv_mbcnt_hi_u32_b32 %0, -1, %0" : "=v"(lane_e));
  const int r32e = lane_e & 31, hie = lane_e >> 5;
  __attribute__((address_space(3))) float* wse = (__attribute__((address_space(3))) float*)(lds + WS_OFF) + wid * 64;
  if (hie == 0) wse[r32e] = l;
  __syncthreads();
  lptr xb = lds + wq * (32 * 128 * 4) + (4 * hie * 128 + r32e) * 4;
  lptr wl = (lptr)wse + 4 * hie * 4;
  asm volatile("" : "+v"(xb), "+v"(wl));
#define CR(r) (((r) & 3) + 8 * ((r) >> 2))
  if (comp == 1) {
#pragma unroll
    for (int r = 0; r < 16; ++r) { const float c1 = lam * __builtin_amdgcn_rcpf(LDSV(float, wl + CR(r) * 4));
#pragma unroll
      for (int d0 = 0; d0 < 4; ++d0) LDSV(float, xb + CR(r) * 512 + d0 * 128) = o[d0][r] * c1; }
  }
  __syncthreads();
  if (comp == 0) {
    float gs[4];
#pragma unroll
    for (int d0 = 0; d0 < 4; ++d0) gs[d0] = gsub[d0 * 32 + r32e] * oscale;
    char* Ow = (char*)(Ob + (long)(wq * QBLK) * LDO);
    unsigned lofs = (unsigned)((4 * hie * LDO + r32e) * 2); asm volatile("" : "+v"(lofs));
#pragma unroll
    for (int r = 0; r < 16; ++r) {
      const float c0 = __builtin_amdgcn_rcpf(LDSV(float, wl + CR(r) * 4));
      float v[4]; float ss = 0.f;
#pragma unroll
      for (int d0 = 0; d0 < 4; ++d0) { v[d0] = o[d0][r] * c0 - LDSV(float, xb + CR(r) * 512 + d0 * 128); ss += v[d0] * v[d0]; }
      ss += sx<1>(ss); ss += sx<2>(ss); ss += sx<4>(ss); ss += sx<8>(ss); ss += sx<16>(ss);
      const float rs = __builtin_amdgcn_rsqf(ss * (1.0f / 128.0f) + eps);
#pragma unroll
      for (int d0 = 0; d0 < 4; ++d0) { const unsigned w = cvtpk(v[d0] * rs * gs[d0], 0.f); *(__attribute__((address_space(1))) bf16_t*)(Ow + (size_t)(CR(r) * LDO * 2 + d0 * 64) + lofs) = (bf16_t)(w & 0xffffu); }
    }
  }
#undef CR
  __syncthreads();
}
#undef LDSV
#undef KSWZ
#undef SBAR
}

constexpr int NWAVES = 8;
constexpr int BATCH = 2, SEQ = 8192, DM = 2048, DEPTH = 4, M = BATCH * SEQ;
constexpr int DFF = 5632, DIN = 8192, DFOUR = 1024, NHEAD = 8, QKD = 64, VD = 128;
constexpr float EPS = 1e-6f;
constexpr int ZC_UF = 0, ZC_Q = 1024, ZC_K = 2048, ZC_V = 3072, ZC_GF = 4096, ZC_GA = 6144;

constexpr size_t MiB = 1u << 20;
constexpr size_t WS_CTL = 0, CTL_ZERO_BYTES = 2 * MiB;
constexpr size_t WS_ROPE = 2 * MiB;
constexpr size_t WS_DFTC = 2 * MiB + 512 * 1024;
constexpr size_t WS_WBIG = WS_DFTC + 256 * 1024;
constexpr size_t WS_W2P  = WS_WBIG + 128 * 1024;
constexpr size_t WS_TW   = WS_W2P + 64 * 1024;
constexpr size_t WS_W = 3 * MiB, W_LAYER = 180 * MiB;
constexpr size_t WL_GUA = 0, WL_DA = 44 * MiB, WL_IN = 66 * MiB, WL_PF = 98 * MiB, WL_PA = 102 * MiB, WL_WO = 106 * MiB, WL_GUB = 114 * MiB, WL_DB = 158 * MiB;
constexpr size_t WS_H = WS_W + 4 * W_LAYER;
constexpr size_t WS_Z = WS_H + 64 * MiB;
constexpr size_t WS_QN = WS_Z + 256 * MiB, WS_KN = WS_QN + 32 * MiB;
constexpr size_t WS_ZT = WS_KN + 32 * MiB;
constexpr size_t WS_Y2 = WS_ZT + 64 * MiB;
constexpr size_t WS_F = WS_Y2 + 64 * MiB, WS_O = WS_F + 32 * MiB, WS_VN = WS_O + 32 * MiB, WS_END = WS_VN + 32 * MiB;
static_assert(WS_TW + 64 * 1024 <= WS_W, "tables fit below the weights");
constexpr int CW_BAR = 4096;
constexpr size_t WS_SSACC = 64 * 1024;
constexpr size_t WS_SSFFA = WS_SSACC + 8 * 131072;
static_assert(WS_SSFFA + 4 * 131072 <= CTL_ZERO_BYTES, "statistics inside the control region");
constexpr float SS_FIX = 1048576.0f, SS_INV = 1.0f / (1048576.0f * 2048.0f);

constexpr int RING_OFF = 0, RING_BYTES = 131072;
constexpr int LDSCTL_OFF = RING_BYTES + 4096, MISC_OFF = LDSCTL_OFF + 320;
constexpr int LDS_BYTES = 147456;

#define GAS __attribute__((address_space(1)))
#define LAS __attribute__((address_space(3)))
typedef unsigned short bf16;
typedef unsigned v4u __attribute__((ext_vector_type(4)));
typedef float f32x4 __attribute__((ext_vector_type(4)));
typedef GAS unsigned gu32;
#define RLX_AGENT __ATOMIC_RELAXED, __HIP_MEMORY_SCOPE_AGENT
#define LDS_WAIT() asm volatile("s_waitcnt lgkmcnt(0)" ::: "memory")
__device__ __forceinline__ unsigned f2bf(float f) { unsigned u = __builtin_bit_cast(unsigned, f); return (u + 0x7fffu + ((u >> 16) & 1u)) >> 16; }
__device__ __forceinline__ unsigned pk2(float lo, float hi) { return f2bf(lo) | (f2bf(hi) << 16); }

#define XB_TMO      128
#define XB_XCNT(j)  (256  + 64 * (j))
#define XB_XSUB(j)  (1280 + 64 * (j))
#define XB_XGEN(j)  (2304 + 64 * (j))
#define XB_TOP      3328
#define XB_TOPGEN   3392
#define XCD_BAR_WORDS 3456
#define XB_SPIN_CAP (1u << 18)
__device__ __forceinline__ unsigned xb_ld(unsigned* p)              { return __hip_atomic_load(p, __ATOMIC_RELAXED, __HIP_MEMORY_SCOPE_AGENT); }
__device__ __forceinline__ unsigned xb_add(unsigned* p, unsigned v) { return __hip_atomic_fetch_add(p, v, __ATOMIC_RELAXED, __HIP_MEMORY_SCOPE_AGENT); }
__device__ __forceinline__ unsigned xb_xcc_id() { return (unsigned)__builtin_amdgcn_s_getreg((3 << 11) | 20) & 0xFu; }
#define XB_SPIN(cond, bar) do { unsigned _sp = 0; while (cond) { __builtin_amdgcn_s_sleep(1); \
    if ((++_sp & 255u) == 0u) { if (xb_ld(&(bar)[XB_TMO])) break; if (_sp > XB_SPIN_CAP) { atomicAdd(&(bar)[XB_TMO], 1u); break; } } } } while (0)
struct XcdBarrier { unsigned* bar; unsigned x; volatile LAS unsigned* st; };
__device__ __forceinline__ XcdBarrier xcd_barrier_post(unsigned* bar, volatile LAS unsigned* st) {
    XcdBarrier b; b.bar = bar; b.x = xb_xcc_id(); b.st = st;
    if (threadIdx.x == 0) (void)xb_add(&bar[XB_XCNT(b.x)], 1u);
    return b;
}
__device__ __forceinline__ void xcd_barrier_complete(unsigned* bar, unsigned x, unsigned& nloc, unsigned& nx) {
    const unsigned G = gridDim.x * gridDim.y * gridDim.z;
    unsigned sum, cnt, mine, sp = 0u;
    for (;;) {
        sum = 0u; cnt = 0u; mine = 0u;
#pragma unroll
        for (unsigned j = 0; j < 16; ++j) { const unsigned c = xb_ld(&bar[XB_XCNT(j)]); sum += c; cnt += (c > 0u) ? 1u : 0u; mine = (j == x) ? c : mine; }
        if (sum == G) break;
        __builtin_amdgcn_s_sleep(1);
        if ((++sp & 255u) == 0u) { if (xb_ld(&bar[XB_TMO])) break; if (sp > XB_SPIN_CAP) { atomicAdd(&bar[XB_TMO], 1u); break; } }
    }
    nloc = mine > 0u ? mine : 1u; nx = cnt > 0u ? cnt : 1u;
}
__device__ __forceinline__ void xcd_barrier(const XcdBarrier& b) {
    asm volatile("s_waitcnt vmcnt(0)" ::: "memory");
    __syncthreads();
    if (threadIdx.x == 0) {
        unsigned* bar = b.bar;
        __builtin_amdgcn_s_waitcnt(0);
        unsigned nloc = b.st[0], nx = b.st[1];
        if (nloc == 0u) { xcd_barrier_complete(bar, b.x, nloc, nx); b.st[0] = nloc; b.st[1] = nx; }
        const unsigned old = xb_add(&bar[XB_XSUB(b.x)], 1u);
        const unsigned gen = old / nloc;
        if (old + 1u == (gen + 1u) * nloc) {
            __builtin_amdgcn_fence(__ATOMIC_RELEASE, "agent");
            asm volatile("s_waitcnt vmcnt(0)" ::: "memory");
            const unsigned og = xb_add(&bar[XB_TOP], 1u);
            const unsigned tg = og / nx;
            if (og + 1u == (tg + 1u) * nx) xb_add(&bar[XB_TOPGEN], 1u);
            else XB_SPIN(xb_ld(&bar[XB_TOPGEN]) == tg, bar);
            __builtin_amdgcn_fence(__ATOMIC_ACQUIRE, "agent");
            xb_add(&bar[XB_XGEN(b.x)], 1u);
            asm volatile("s_waitcnt vmcnt(0)" ::: "memory");
        } else {
            XB_SPIN(xb_ld(&bar[XB_XGEN(b.x)]) == gen, bar);
            __builtin_amdgcn_fence(__ATOMIC_ACQUIRE, "agent");
            asm volatile("s_waitcnt vmcnt(0)" ::: "memory");
        }
    }
    __syncthreads();
}

template <int X> __device__ __forceinline__ float swz_xor(float v) { return __int_as_float(__builtin_amdgcn_ds_swizzle(__float_as_int(v), 0x1f | (X << 10))); }
__device__ __forceinline__ float half_swap(float v) { auto rr = __builtin_amdgcn_permlane32_swap(__float_as_uint(v), __float_as_uint(v), false, false); return __uint_as_float(rr[0]) + __uint_as_float(rr[1]) - v; }
__device__ __forceinline__ float wave_sum(float v) {
    v += swz_xor<1>(v); v += swz_xor<2>(v); v += swz_xor<4>(v); v += swz_xor<8>(v); v += swz_xor<16>(v);
    { auto rr = __builtin_amdgcn_permlane32_swap(__float_as_uint(v), __float_as_uint(v), false, false); v = __uint_as_float(rr[0]) + __uint_as_float(rr[1]); }
    return v;
}
__device__ __forceinline__ float wave_max(float v) {
    v = fmaxf(v, swz_xor<1>(v)); v = fmaxf(v, swz_xor<2>(v)); v = fmaxf(v, swz_xor<4>(v)); v = fmaxf(v, swz_xor<8>(v)); v = fmaxf(v, swz_xor<16>(v));
    { auto rr = __builtin_amdgcn_permlane32_swap(__float_as_uint(v), __float_as_uint(v), false, false); v = fmaxf(__uint_as_float(rr[0]), __uint_as_float(rr[1])); }
    return v;
}
__device__ __forceinline__ void transpose_item(const float* W, int K, int N, bf16* WT, int map, LAS float* scr, int item, int lane, const float* gk = nullptr) {
    const int nblk = N / 32, kb = item / nblk, nb = item % nblk, k0 = 64 * kb, n0 = 32 * nb;
    const int r0 = (map == 0 || map == 3) ? n0 : (256 * (n0 >> 7) + (n0 & 127) + (map == 2 ? 128 : 0));
    const bool qkperm = (map == 3) && n0 >= 1024 && n0 < 3072;
#pragma unroll 8
    for (int i = 0; i < 32; ++i) { const int kk = 2 * i + (lane >> 5); scr[kk * 33 + (lane & 31)] = W[(size_t)(k0 + kk) * N + n0 + (lane & 31)]; }
    LDS_WAIT(); asm volatile("" ::: "memory");
    const int c = lane & 7;
    f32x4 ga = (f32x4){1.f, 1.f, 1.f, 1.f}, gb = ga;
    if (gk) { ga = *(const GAS f32x4*)(gk + k0 + 8 * c); gb = *(const GAS f32x4*)(gk + k0 + 8 * c + 4); }
#pragma unroll
    for (int j = 0; j < 4; ++j) { const int n = (lane >> 3) + 8 * j; const LAS float* s = scr + (8 * c) * 33 + n;
        v4u o; o.x = pk2(s[0 * 33] * ga.x, s[1 * 33] * ga.y); o.y = pk2(s[2 * 33] * ga.z, s[3 * 33] * ga.w); o.z = pk2(s[4 * 33] * gb.x, s[5 * 33] * gb.y); o.w = pk2(s[6 * 33] * gb.z, s[7 * 33] * gb.w);
        int rr = r0 + n;
        if (qkperm) { const int cc = n0 + n - 1024, hc = cc >> 6, d = cc & 63; rr = 1024 + 256 * (hc >> 2) + 128 * ((d >> 3) & 1) + 32 * (hc & 3) + 8 * (d >> 4) + 4 * ((d >> 2) & 1) + (d & 3); }
        *(GAS v4u*)(WT + (size_t)rr * K + k0 + 8 * c) = o; }
    LDS_WAIT(); asm volatile("" ::: "memory");
}
__device__ __forceinline__ void rms_row_to_bf16(const float* xrow, const f32x4 (&g)[8], bf16* orow, int lane) {
    const GAS f32x4* xr = (const GAS f32x4*)xrow + lane;
    f32x4 v[8]; float s = 0.f;
#pragma unroll
    for (int j = 0; j < 8; ++j) { v[j] = xr[64 * j]; s += (v[j].x * v[j].x + v[j].y * v[j].y) + (v[j].z * v[j].z + v[j].w * v[j].w); }
    const float rstd = 1.f / sqrtf(wave_sum(s) * (1.f / DM) + EPS);
    GAS unsigned long long* o8 = (GAS unsigned long long*)orow + lane;
#pragma unroll
    for (int j = 0; j < 8; ++j) { const f32x4 y = v[j] * rstd * g[j]; o8[64 * j] = (unsigned long long)pk2(y.x, y.y) | ((unsigned long long)pk2(y.z, y.w) << 32); }
}

__device__ __forceinline__ float row_to_bf16_ss(const float* xrow, bf16* orow, int lane) {
    const GAS f32x4* xr = (const GAS f32x4*)xrow + lane;
    GAS unsigned long long* o8 = (GAS unsigned long long*)orow + lane;
    float s = 0.f;
#pragma unroll
    for (int j = 0; j < 8; ++j) { const f32x4 v = xr[64 * j]; s += (v.x * v.x + v.y * v.y) + (v.z * v.z + v.w * v.w); o8[64 * j] = (unsigned long long)pk2(v.x, v.y) | ((unsigned long long)pk2(v.z, v.w) << 32); }
    return wave_sum(s);
}

struct Args { const float* in[22]; float* out; unsigned char* ws; int ph_lo, ph_hi; };


struct EpiWin {
    struct State { float rs[8]; };
    const Args* ka; const unsigned long long* ss; const float* gq; const float* gk;
    __device__ __forceinline__ void init(pg8::f32x4 (&acc)[2][2][4][2], State& st, const pg8::Unit& u, int wr, int, int fr, int) const {
        using pg8::f32x4; using pg8::BM; using pg8::HALF;
#pragma unroll
        for (int ai = 0; ai < 2; ++ai)
#pragma unroll
            for (int m = 0; m < 4; ++m) st.rs[ai * 4 + m] = __builtin_amdgcn_rsqf((float)ss[u.pm * BM + ai * HALF + wr * 64 + m * 16 + fr] * (1.0f / (1048576.0f * 2048.0f)) + 1e-6f);
#pragma unroll
        for (int a = 0; a < 2; ++a)
#pragma unroll
            for (int b = 0; b < 2; ++b)
#pragma unroll
                for (int m = 0; m < 4; ++m)
#pragma unroll
                    for (int n = 0; n < 2; ++n) acc[a][b][m][n] = (f32x4){0.f, 0.f, 0.f, 0.f};
    }
    __device__ __forceinline__ void operator()(const pg8::f32x4 (&acc)[2][2][4][2], const State& st, const pg8::Unit& u, int wr, int wc, int fr, int fq) const {
        using pg8::f32x4; using pg8::u32x4; using pg8::BM; using pg8::HALF; using pg8::cvt_pk_bf16;
        GAS unsigned char* wsb = (GAS unsigned char*)ka->ws;
        if (u.pn < 4 || u.pn >= 16) {
            GAS bf16* Z = (GAS bf16*)(wsb + WS_Z); const int col0 = u.pn * BM + wc * 32 + 8 * fq;
#pragma unroll
            for (int ai = 0; ai < 2; ++ai)
#pragma unroll
                for (int m = 0; m < 4; ++m) { const int row = u.pm * BM + ai * HALF + wr * 64 + m * 16 + fr; const float rs = st.rs[ai * 4 + m];
#pragma unroll
                    for (int bj = 0; bj < 2; ++bj) { const f32x4 v0 = acc[ai][bj][m][0] * rs, v1 = acc[ai][bj][m][1] * rs;
                        u32x4 w; w.x = cvt_pk_bf16(v0[0], v0[1]); w.y = cvt_pk_bf16(v0[2], v0[3]); w.z = cvt_pk_bf16(v1[0], v1[1]); w.w = cvt_pk_bf16(v1[2], v1[3]);
                        *(GAS u32x4*)(Z + (size_t)row * DIN + col0 + bj * HALF) = w; } }
        } else if (u.pn >= 12) {
            GAS bf16* V = (GAS bf16*)(wsb + WS_VN);
#pragma unroll
            for (int ai = 0; ai < 2; ++ai)
#pragma unroll
                for (int m = 0; m < 4; ++m) { const int row = u.pm * BM + ai * HALF + wr * 64 + m * 16 + fr; const float rs = st.rs[ai * 4 + m]; const int b = row >> 13, sq = row & 8191;
#pragma unroll
                    for (int bj = 0; bj < 2; ++bj) { const f32x4 v0 = acc[ai][bj][m][0] * rs, v1 = acc[ai][bj][m][1] * rs;
                        u32x4 w; w.x = cvt_pk_bf16(v0[0], v0[1]); w.y = cvt_pk_bf16(v0[2], v0[3]); w.z = cvt_pk_bf16(v1[0], v1[1]); w.w = cvt_pk_bf16(v1[2], v1[3]);
                        *(GAS u32x4*)(V + ((size_t)((b * NHEAD + 2 * (u.pn - 12) + bj) * SEQ + sq) * 128) + wc * 32 + 8 * fq) = w; } }
        } else {
            const int hca = 4 * (u.pn - 4) + wc, isk = hca >> 4, hc = hca & 15, hh = hc >> 1, cmp = hc & 1;
            GAS bf16* D = (GAS bf16*)(wsb + (isk ? WS_KN : WS_QN)); const GAS float* gg = (const GAS float*)(isk ? gk : gq) + 16 * fq;
            const GAS float* rope = (const GAS float*)(wsb + WS_ROPE);
            f32x4 g4[2][2];
#pragma unroll
            for (int bj = 0; bj < 2; ++bj)
#pragma unroll
                for (int n = 0; n < 2; ++n) g4[bj][n] = *(const GAS f32x4*)(gg + 8 * bj + 4 * n);
            const float qs = isk ? 1.0f : 0.125f * 1.4426950408889634f;
#pragma unroll
            for (int ai = 0; ai < 2; ++ai)
#pragma unroll
                for (int m = 0; m < 4; ++m) { const int row = u.pm * BM + ai * HALF + wr * 64 + m * 16 + fr; const float rs = st.rs[ai * 4 + m]; const int b = row >> 13, sq = row & 8191;
                    f32x4 x[2][2]; float q2 = 0.f;
#pragma unroll
                    for (int bj = 0; bj < 2; ++bj)
#pragma unroll
                        for (int n = 0; n < 2; ++n) { x[bj][n] = acc[ai][bj][m][n] * rs; q2 += (x[bj][n][0] * x[bj][n][0] + x[bj][n][1] * x[bj][n][1]) + (x[bj][n][2] * x[bj][n][2] + x[bj][n][3] * x[bj][n][3]); }
                    q2 += __int_as_float(__builtin_amdgcn_ds_swizzle(__float_as_int(q2), 0x1f | (16 << 10)));
                    { auto rr = __builtin_amdgcn_permlane32_swap(__float_as_uint(q2), __float_as_uint(q2), false, false); q2 = __uint_as_float(rr[0]) + __uint_as_float(rr[1]); }
                    const float rh = __builtin_amdgcn_rsqf(q2 * (1.0f / 64.0f) + 1e-6f);
#pragma unroll
                    for (int bj = 0; bj < 2; ++bj)
#pragma unroll
                        for (int n = 0; n < 2; ++n) x[bj][n] = x[bj][n] * rh * g4[bj][n];
                    if (fq == 0) {
                        const f32x4 c0 = *(const GAS f32x4*)(rope + sq * 16), c1 = *(const GAS f32x4*)(rope + sq * 16 + 4), s0 = *(const GAS f32x4*)(rope + sq * 16 + 8), s1 = *(const GAS f32x4*)(rope + sq * 16 + 12);
                        const f32x4 a0 = x[0][0], a1 = x[0][1], b0 = x[1][0], b1 = x[1][1];
                        x[0][0] = a0 * c0 - b0 * s0; x[0][1] = a1 * c1 - b1 * s1; x[1][0] = b0 * c0 + a0 * s0; x[1][1] = b1 * c1 + a1 * s1; }
                    GAS bf16* dp = D + ((size_t)((b * NHEAD + hh) * SEQ + sq) * 128) + cmp * 64 + 16 * fq;
#pragma unroll
                    for (int bj = 0; bj < 2; ++bj) { const f32x4 v0 = x[bj][0] * qs, v1 = x[bj][1] * qs;
                        u32x4 w; w.x = cvt_pk_bf16(v0[0], v0[1]); w.y = cvt_pk_bf16(v0[2], v0[3]); w.z = cvt_pk_bf16(v1[0], v1[1]); w.w = cvt_pk_bf16(v1[2], v1[3]);
                        *(GAS u32x4*)(dp + 8 * bj) = w; } }
        }
    }
};
template <int ALPHA2> struct EpiResid {
    struct State { };
    const Args* ka; int base_in; unsigned ss_off;
    __device__ __forceinline__ void init(pg8::f32x4 (&acc)[2][2][4][2], State&, const pg8::Unit& u, int wr, int wc, int fr, int fq) const {
        using pg8::f32x4; using pg8::BM; using pg8::HALF;
        const int col0 = u.pn * BM + wc * 32 + 8 * fq;
        if (base_in) {
            const GAS float* base = (const GAS float*)ka->in[0];
#pragma unroll
            for (int ai = 0; ai < 2; ++ai)
#pragma unroll
                for (int m = 0; m < 4; ++m) { const size_t off = (size_t)(u.pm * BM + ai * HALF + wr * 64 + m * 16 + fr) * DM + col0;
#pragma unroll
                    for (int bj = 0; bj < 2; ++bj)
#pragma unroll
                        for (int n = 0; n < 2; ++n) acc[ai][bj][m][n] = *(const GAS f32x4*)(base + off + bj * HALF + 4 * n) * (2.0f / ALPHA2); }
        } else {
            const GAS bf16* xb = (const GAS bf16*)((GAS unsigned char*)ka->ws + WS_H);
#pragma unroll
            for (int ai = 0; ai < 2; ++ai)
#pragma unroll
                for (int m = 0; m < 4; ++m) { const size_t off = (size_t)(u.pm * BM + ai * HALF + wr * 64 + m * 16 + fr) * DM + col0;
#pragma unroll
                    for (int bj = 0; bj < 2; ++bj) { const pg8::u32x4 w = *(const GAS pg8::u32x4*)(xb + off + bj * HALF);
                        acc[ai][bj][m][0] = (f32x4){pg8::bf_lo(w.x), pg8::bf_hi(w.x), pg8::bf_lo(w.y), pg8::bf_hi(w.y)} * (2.0f / ALPHA2);
                        acc[ai][bj][m][1] = (f32x4){pg8::bf_lo(w.z), pg8::bf_hi(w.z), pg8::bf_lo(w.w), pg8::bf_hi(w.w)} * (2.0f / ALPHA2); } }
        }
    }
    __device__ __forceinline__ void operator()(const pg8::f32x4 (&acc)[2][2][4][2], const State& st, const pg8::Unit& u, int wr, int wc, int fr, int fq) const {
        using pg8::f32x4; using pg8::u32x4; using pg8::BM; using pg8::HALF;
        GAS unsigned char* wsb = (GAS unsigned char*)ka->ws; GAS bf16* xb = (GAS bf16*)(wsb + WS_H); GAS unsigned long long* ssacc = (GAS unsigned long long*)(wsb + ss_off);
        const float alpha = 0.5f * ALPHA2;
        const int col0 = u.pn * BM + wc * 32 + 8 * fq;
#pragma unroll
        for (int ai = 0; ai < 2; ++ai)
#pragma unroll
            for (int m = 0; m < 4; ++m) { const int row = u.pm * BM + ai * HALF + wr * 64 + m * 16 + fr;
            const size_t off = (size_t)row * DM + col0;
            float q = 0.f;
#pragma unroll
            for (int bj = 0; bj < 2; ++bj) { f32x4 b[2];
#pragma unroll
                for (int n = 0; n < 2; ++n) { b[n] = acc[ai][bj][m][n] * alpha;
                    q += (b[n][0] * b[n][0] + b[n][1] * b[n][1]) + (b[n][2] * b[n][2] + b[n][3] * b[n][3]); }
                u32x4 w; w.x = pg8::cvt_pk_bf16(b[0][0], b[0][1]); w.y = pg8::cvt_pk_bf16(b[0][2], b[0][3]); w.z = pg8::cvt_pk_bf16(b[1][0], b[1][1]); w.w = pg8::cvt_pk_bf16(b[1][2], b[1][3]);
                *(GAS u32x4*)(xb + off + bj * HALF) = w; }
            q += __int_as_float(__builtin_amdgcn_ds_swizzle(__float_as_int(q), 0x1f | (16 << 10)));
            { auto rr = __builtin_amdgcn_permlane32_swap(__float_as_uint(q), __float_as_uint(q), false, false); q = __uint_as_float(rr[0]) + __uint_as_float(rr[1]); }
            if (fq == 0) __hip_atomic_fetch_add(ssacc + row, (unsigned long long)(q * SS_FIX + 0.5f), __ATOMIC_RELAXED, __HIP_MEMORY_SCOPE_AGENT);
        }
    }
};


__global__ void __launch_bounds__(NWAVES * 64, 2) enc_fwd(Args args) {
    extern __shared__ __attribute__((aligned(16))) unsigned char lds[];
    LAS unsigned char* const L = (LAS unsigned char*)lds;
    volatile LAS unsigned* MISC = (volatile LAS unsigned*)(L + MISC_OFF);
    const int wave0 = __builtin_amdgcn_readfirstlane(threadIdx.x >> 6);
#define LANE_SETUP() int G = gridDim.x, bx = blockIdx.x; asm volatile("" : "+s"(G), "+s"(bx)); const int vcu = (G % 8 == 0) ? (bx % 8) * (G / 8) + bx / 8 : bx; const int NGW = G * NWAVES; (void)NGW; int lane_; asm volatile("v_mbcnt_lo_u32_b32 %0, -1, 0\n\tv_mbcnt_hi_u32_b32 %0, -1, %0" : "=v"(lane_)); int wave = wave0; asm volatile("" : "+s"(wave)); const int lane = lane_, tid = wave * 64 + lane; (void)tid; const int gw = vcu * NWAVES + wave; (void)lane; (void)gw
    gu32* ctl = (gu32*)(args.ws + WS_CTL);
#define Hb ((bf16*)(GAS bf16*)(ws + WS_H))
#define SSACC(i) ((unsigned long long*)(GAS unsigned long long*)(ws + WS_SSACC) + (size_t)(i) * M)
#define SSFFA(i) ((unsigned long long*)(GAS unsigned long long*)(ws + WS_SSFFA) + (size_t)(i) * M)
#define Zb ((bf16*)(GAS bf16*)(ws + WS_Z))
#define HID ((bf16*)(GAS bf16*)(ws + WS_Z))
#define QN ((bf16*)(GAS bf16*)(ws + WS_QN))
#define KN ((bf16*)(GAS bf16*)(ws + WS_KN))
#define VN ((bf16*)(GAS bf16*)(ws + WS_VN))
#define ZT ((bf16*)(GAS bf16*)(ws + WS_ZT))
#define MB ((bf16*)(GAS bf16*)(ws + WS_ZT))
#define Fb ((bf16*)(GAS bf16*)(ws + WS_F))
#define Ob ((bf16*)(GAS bf16*)(ws + WS_O))
#define ROPE ((float*)(GAS float*)(ws + WS_ROPE))
#define DFTC ((bf16*)(GAS bf16*)(ws + WS_DFTC))
#define WBIG ((bf16*)(GAS bf16*)(ws + WS_WBIG))
#define W2P ((bf16*)(GAS bf16*)(ws + WS_W2P))
#define TWT ((float*)(GAS float*)(ws + WS_TW))
#define Y2b ((bf16*)(GAS bf16*)(ws + WS_Y2))
#define x_in (args.in[0])
#define xo   (args.out)
#define PH_SETUP() GAS unsigned char* ws = (GAS unsigned char*)args.ws; asm volatile("" : "+s"(ws)); int layer = hl >> 1; asm volatile("" : "+s"(layer)); GAS unsigned char* wl = ws + WS_W + (size_t)layer * W_LAYER; (void)wl; LANE_SETUP()
    for (int u = threadIdx.x; u < (LDS_BYTES - LDSCTL_OFF) / 4; u += NWAVES * 64) ((LAS unsigned*)(L + LDSCTL_OFF))[u] = 0u;
    __syncthreads();
    XcdBarrier bar; bar.bar = (unsigned*)(ctl + CW_BAR); bar.x = 0; bar.st = nullptr;
    if (MK_ONE_LAUNCH) bar = xcd_barrier_post((unsigned*)(ctl + CW_BAR), MISC + 8);
    const int lo = args.ph_lo, hi = args.ph_hi;
    int ph = 0;
#define IN_PH() (lo <= ph && ph < hi)
#define END_PH() do { if (MK_ONE_LAUNCH && lo <= ph && ph + 1 < hi) xcd_barrier(bar); ++ph; } while (0)

    if (IN_PH()) { {
        GAS unsigned char* ws = (GAS unsigned char*)args.ws; asm volatile("" : "+s"(ws)); LANE_SETUP();
        LAS float* scr = (LAS float*)(L + RING_OFF + wave * 16384);
        constexpr int I_G = (DM / 64) * (DFF / 32), I_D = (DFF / 64) * (DM / 32), I_IN = (DM / 64) * (DIN / 32), I_P = (DFOUR / 64) * (DM / 32), I_O = (DM / 64) * (DM / 32);
        constexpr int C1 = I_G, C2 = C1 + I_G, C3 = C2 + I_D, C4 = C3 + I_IN, C5 = C4 + I_P, C6 = C5 + I_P, C7 = C6 + I_O, C8 = C7 + I_G, C9 = C8 + I_G, C10 = C9 + I_D;
        for (int layer = 0; layer < DEPTH; ++layer) {
            GAS unsigned char* wl = ws + WS_W + (size_t)layer * W_LAYER;
            const float* gate_a = args.in[2] + (size_t)layer * DM * DFF; const float* up_a = args.in[3] + (size_t)layer * DM * DFF; const float* down_a = args.in[4] + (size_t)layer * DFF * DM;
            const float* w_in = args.in[6] + (size_t)layer * DM * DIN; const float* p_f = args.in[14] + (size_t)layer * DFOUR * DM; const float* p_a = args.in[15] + (size_t)layer * DFOUR * DM;
            const float* w_o = args.in[16] + (size_t)layer * DM * DM;
            const float* gate_b = args.in[18] + (size_t)layer * DM * DFF; const float* up_b = args.in[19] + (size_t)layer * DM * DFF; const float* down_b = args.in[20] + (size_t)layer * DFF * DM;
            for (int it = gw; it < C10; it += NGW) {
                if (it < C1)      transpose_item(gate_a, DM, DFF, (bf16*)(wl + WL_GUA), 1, scr, it, lane, args.in[1] + (size_t)layer * DM);
                else if (it < C2) transpose_item(up_a, DM, DFF, (bf16*)(wl + WL_GUA), 2, scr, it - C1, lane, args.in[1] + (size_t)layer * DM);
                else if (it < C3) transpose_item(down_a, DFF, DM, (bf16*)(wl + WL_DA), 0, scr, it - C2, lane);
                else if (it < C4) transpose_item(w_in, DM, DIN, (bf16*)(wl + WL_IN), 3, scr, it - C3, lane, args.in[5] + (size_t)layer * DM);
                else if (it < C5) transpose_item(p_f, DFOUR, DM, (bf16*)(wl + WL_PF), 0, scr, it - C4, lane);
                else if (it < C6) transpose_item(p_a, DFOUR, DM, (bf16*)(wl + WL_PA), 0, scr, it - C5, lane);
                else if (it < C7) transpose_item(w_o, DM, DM, (bf16*)(wl + WL_WO), 0, scr, it - C6, lane);
                else if (it < C8) transpose_item(gate_b, DM, DFF, (bf16*)(wl + WL_GUB), 1, scr, it - C7, lane, args.in[17] + (size_t)layer * DM);
                else if (it < C9) transpose_item(up_b, DM, DFF, (bf16*)(wl + WL_GUB), 2, scr, it - C8, lane, args.in[17] + (size_t)layer * DM);
                else              transpose_item(down_b, DFF, DM, (bf16*)(wl + WL_DB), 0, scr, it - C9, lane);
            }
        }
        const int gt = (vcu * NWAVES + wave) * 64 + lane, NGT = NGW * 64;
        for (int i = gt; i < 256 * 256; i += NGT) { const int r = i >> 8, c = i & 255, pr = r >> 7, s1p = r & 127, pc = c >> 7, s1 = c & 127, j = (s1 * s1p) & 127;
            float sn, cs; sincospif((float)j * (1.0f / 64.0f), &sn, &cs); WBIG[i] = (bf16)f2bf(pr == pc ? cs : (pr ? sn : -sn)); }
        for (int i = gt; i < 256 * 128; i += NGT) { const int r = i >> 7, c = i & 127, pc = c >> 6, s2 = c & 63, j = (s2 * r) & 63;
            float sn, cs; sincospif((float)j * (1.0f / 32.0f), &sn, &cs); W2P[i] = (bf16)f2bf(r < 64 ? (pc ? -sn : cs) : 0.0f); }
        for (int i = gt; i < 128 * 64; i += NGT) { const int s1p = i >> 6, s2 = i & 63; float sn, cs; sincospif((float)(s1p * s2) * (1.0f / 4096.0f), &sn, &cs); TWT[2 * i] = cs; TWT[2 * i + 1] = sn; }
        for (int i = gt; i < 512 * 256; i += NGT) { const int r = i >> 8, c = i & 255, part = r >> 8, cp = r & 255, j = (c * cp) & 255;
            float sn, cs; sincospif((float)j * (1.0f / 128.0f), &sn, &cs); DFTC[i] = (bf16)f2bf((part ? sn : cs) * 0.0625f); }
        for (int i = gt; i < SEQ * 8; i += NGT) { const int s = i >> 3, j = i & 7;
            const double inv = j == 0 ? 1.0 : j == 1 ? 0.19392274474868576 : j == 2 ? 0.03760603093086393 : j == 3 ? 0.007292664737217109 : j == 4 ? 0.001414213562373095 : j == 5 ? 0.0002742481756762073 : j == 6 ? 5.318295896944988e-05 : 1.031338537721246e-05;
            const double rev = (double)s * inv * 0.15915494309189535;
            const float fr = (float)(rev - __builtin_rint(rev)); float sn, cs; sincospif(2.0f * fr, &sn, &cs);
            ROPE[s * 16 + j] = cs; ROPE[s * 16 + 8 + j] = sn; }
        for (int m = gw; m < M; m += NGW) { const float ssq = row_to_bf16_ss(x_in + (size_t)m * DM, Hb + (size_t)m * DM, lane); if (lane == 0) SSFFA(0)[m] = (unsigned long long)(ssq * SS_FIX + 0.5f); }
    } }
    END_PH();

    for (int hl = 0; hl < 2 * DEPTH; ++hl) {
        const int ff = hl & 1;
        if (IN_PH()) { PH_SETUP();
            pg8::Prob g = pg8::mk_prob(Hb, (const char*)(wl + (ff ? WL_GUB : WL_GUA)), DM * 2, DM * 2, 0, 0, DM);
            pg8::GridOrder S; S.init(M / 256, 2 * DFF / 256, 1, G, bx);
            pg8::EpiSwiglu E{HID, DFF, ff ? SSACC(2 * layer + 1) : SSFFA(layer)};
            pg8::gemm_phase<pg8::EpiSwiglu, pg8::GridOrder, true, true>(L + RING_OFF, g, S, E, tid);
        }
        END_PH();
        if (IN_PH()) { PH_SETUP();
            pg8::Prob g = pg8::mk_prob(HID, (const char*)(wl + (ff ? WL_DB : WL_DA)), DFF * 2, DFF * 2, 0, 0, DFF);
            pg8::GridOrder S; S.init(M / 256, DM / 256, 1, G, bx, 4);
            if (ff == 0) {
                EpiResid<1> E{&args, hl == 0, (unsigned)(WS_SSACC + (size_t)(2 * layer) * M * 8)};
                pg8::gemm_phase<EpiResid<1>, pg8::GridOrder, true, true>(L + RING_OFF, g, S, E, tid);
            } else {
                pg8::EpiBf16 E{Y2b, DM, 1.0f, 0, nullptr};
                pg8::gemm_phase<pg8::EpiBf16, pg8::GridOrder, true, true>(L + RING_OFF, g, S, E, tid);
            }
        }
        END_PH();
        if (ff == 0) {
            if (IN_PH()) { PH_SETUP();
                pg8::Prob g = pg8::mk_prob(Hb, (const char*)(wl + WL_IN), DM * 2, DM * 2, 0, 0, DM);
                pg8::GridOrder S; S.init(M / 256, DIN / 256, 1, G, bx);
                EpiWin E{&args, SSACC(2 * layer), args.in[7] + (size_t)layer * QKD, args.in[8] + (size_t)layer * QKD};
                pg8::gemm_phase<EpiWin, pg8::GridOrder, true, true>(L + RING_OFF, g, S, E, tid);
            }
            END_PH();
            if (IN_PH()) { PH_SETUP();
                pg8::Prob g = pg8::mk_prob(DFTC, (Zb + ZC_UF), 256 * 2, 64 * DIN * 2, 0, 256 * 2, 256);
                g.hsB = DIN * 2; g.m0 = 31u; g.s0 = (size_t)2 * DIN * 2; g.sh1 = 5; g.m1 = 1u; g.s1 = (size_t)SEQ * DIN * 2; g.sh2 = 31; g.s2 = 0;
                pg8::GridOrder S; S.init(2, M / 256, 4, G, bx);
                pg8::EpiCstep E{ZT};
                pg8::gemm_phase<pg8::EpiCstep, pg8::GridOrder, true>(L + RING_OFF, g, S, E, tid);
            }
            END_PH();
            if (IN_PH()) { PH_SETUP();
                pg8::Prob g = pg8::mk_prob(WBIG, ZT, 256 * 2, 256 * 2, 0, 0, 256);
                pg8::GridOrder S; S.init(1, (1024 * 2 * 64) / 256, 1, G, bx);
                pg8::EpiS1 E{Y2b, TWT};
                pg8::gemm_phase<pg8::EpiS1, pg8::GridOrder, true>(L + RING_OFF, g, S, E, tid);
            }
            END_PH();
            if (IN_PH()) { PH_SETUP();
                float lam, negshift;
                { const float a = args.in[9][layer * QKD + lane] * args.in[10][layer * QKD + lane], b = args.in[11][layer * QKD + lane] * args.in[12][layer * QKD + lane];
                  const float lam_init = 0.8f - 0.6f * expf(-0.3f * (float)layer);
                  lam = expf(wave_sum(a)) - expf(wave_sum(b)) + lam_init; lam = __builtin_bit_cast(float, __builtin_amdgcn_readfirstlane(__builtin_bit_cast(int, lam)));
                  const float mq = wave_max(fabsf(args.in[7][layer * QKD + lane])), mk = wave_max(fabsf(args.in[8][layer * QKD + lane]));
                  const float bound = 8.0f * 1.4426950408889634f * mq * mk;
                  negshift = -fminf(bound, 60.0f); negshift = __builtin_bit_cast(float, __builtin_amdgcn_readfirstlane(__builtin_bit_cast(int, negshift))); }
                const bool noshift = negshift > -60.0f;
                const float lam_init = __builtin_bit_cast(float, __builtin_amdgcn_readfirstlane(__builtin_bit_cast(int, 0.8f - 0.6f * expf(-0.3f * (float)layer))));
                const float* gsub = args.in[13] + (size_t)layer * VD;
                for (int i = 0; i < 4; ++i) {
                    if (G != 256) break;
                    const int bh = (vcu >> 5) + 8 * (i >> 1), qb = (i & 1) * 32 + (vcu & 31), b = bh >> 3, h = bh & 7;
                    const size_t row0 = (size_t)b * SEQ, hb = (size_t)bh * SEQ * 128;
                    if (noshift) att::attn_unit<false>(QN + hb + (size_t)qb * 128 * 128, KN + hb, VN + hb, Ob + (row0 + qb * 128) * 1024 + h * 128,
                                   SEQ, negshift, lam, gsub, 1.0f - lam_init, EPS, (att::lptr)(L + RING_OFF), wave);
                    else         att::attn_unit<true>(QN + hb + (size_t)qb * 128 * 128, KN + hb, VN + hb, Ob + (row0 + qb * 128) * 1024 + h * 128,
                                   SEQ, negshift, lam, gsub, 1.0f - lam_init, EPS, (att::lptr)(L + RING_OFF), wave);
                }
                pg8::Prob g = pg8::mk_prob(W2P, Y2b, 128 * 2, 2 * 128 * 2, 0, 0, 128);
                g.m0 = 3u; g.s0 = (size_t)256 * 512; g.sh1 = 2; g.m1 = 127u; g.s1 = (size_t)1024 * 512; g.sh2 = 9; g.s2 = 256;
                pg8::GridOrder S; S.init(1, BATCH * 128 * 4, 1, G, bx);
                pg8::EpiS2 E{Fb, 0.011048543456039806f};
                int lane_b; asm volatile("v_mbcnt_lo_u32_b32 %0, -1, 0\n\tv_mbcnt_hi_u32_b32 %0, -1, %0" : "=v"(lane_b));
                pg8::gemm_phase<pg8::EpiS2, pg8::GridOrder, true>(L + RING_OFF, g, S, E, wave * 64 + lane_b);
            }
            END_PH();
            if (IN_PH()) { PH_SETUP();
                pg8::Prob g = pg8::mk_prob(Fb, (const char*)(wl + WL_PF), DFOUR * 2, DFOUR * 2, (size_t)(WS_O - WS_F), (size_t)(WL_PA - WL_PF), DFOUR);
                pg8::GridOrder S; S.init(M / 256, DM / 256, 1, G, bx, pg8::WGM, 2);
                pg8::EpiGate2 E{Zb + ZC_GF, Zb + ZC_GA, DIN, MB, DM};
                pg8::gemm_phase<pg8::EpiGate2, pg8::GridOrder, true>(L + RING_OFF, g, S, E, tid);
            }
            END_PH();
            if (IN_PH()) { PH_SETUP();
                pg8::Prob g = pg8::mk_prob(MB, (const char*)(wl + WL_WO), DM * 2, DM * 2, 0, 0, DM);
                pg8::GridOrder S; S.init(M / 256, DM / 256, 1, G, bx);
                EpiResid<2> E{&args, 0, (unsigned)(WS_SSACC + (size_t)(2 * layer + 1) * M * 8)};
                pg8::gemm_phase<EpiResid<2>, pg8::GridOrder, true, true>(L + RING_OFF, g, S, E, tid);
            }
            END_PH();
        } else {
            if (IN_PH()) { PH_SETUP();
                f32x4 go[8];
                const bool has_next = (layer + 1 < DEPTH);
#pragma unroll
                for (int j = 0; j < 8; ++j) go[j] = *((const GAS f32x4*)(args.in[21] + (size_t)layer * DM) + lane + 64 * j);
                for (int m = gw; m < M; m += NGW) {
                    GAS unsigned long long* xr = (GAS unsigned long long*)(Hb + (size_t)m * DM) + lane;
                    f32x4 v[8]; float s = 0.f;
#pragma unroll
                    for (int j = 0; j < 8; ++j) { const unsigned long long xw = xr[64 * j], yw = ((const GAS unsigned long long*)(Y2b + (size_t)m * DM) + lane)[64 * j];
                        v[j] = (f32x4){pg8::bf_lo((unsigned)xw), pg8::bf_hi((unsigned)xw), pg8::bf_lo((unsigned)(xw >> 32)), pg8::bf_hi((unsigned)(xw >> 32))}
                             + 0.5f * (f32x4){pg8::bf_lo((unsigned)yw), pg8::bf_hi((unsigned)yw), pg8::bf_lo((unsigned)(yw >> 32)), pg8::bf_hi((unsigned)(yw >> 32))};
                        s += (v[j].x * v[j].x + v[j].y * v[j].y) + (v[j].z * v[j].z + v[j].w * v[j].w); }
                    const float rstd = 1.f / sqrtf(wave_sum(s) * (1.f / DM) + EPS);
                    float s2 = 0.f;
#pragma unroll
                    for (int j = 0; j < 8; ++j) { v[j] = v[j] * rstd * go[j]; s2 += (v[j].x * v[j].x + v[j].y * v[j].y) + (v[j].z * v[j].z + v[j].w * v[j].w); }
                    if (has_next) {
                        const float ss2 = wave_sum(s2);
#pragma unroll
                        for (int j = 0; j < 8; ++j) xr[64 * j] = (unsigned long long)pk2(v[j].x, v[j].y) | ((unsigned long long)pk2(v[j].z, v[j].w) << 32);
                        if (lane == 0) SSFFA(layer + 1)[m] = (unsigned long long)(ss2 * SS_FIX + 0.5f);
                    } else {
                        GAS f32x4* orow = (GAS f32x4*)(xo + (size_t)m * DM) + lane;
#pragma unroll
                        for (int j = 0; j < 8; ++j) orow[64 * j] = v[j];
                    }
                }
            }
            END_PH();
        }
    }
#undef IN_PH
#undef END_PH
}

constexpr int N_PHASES = 1 + DEPTH * (2 + 6 + 2 + 1);

extern "C" void kernel_launch(void* const* d_in, const int* in_sizes, int n_in, void* d_out, int out_size, void* d_ws, size_t ws_size, hipStream_t stream) {
    static int grid = 0;
    if (grid == 0) {
        if (n_in != 22 || in_sizes[0] != M * DM || out_size != M * DM || ws_size < WS_END) {
            fprintf(stderr, "kernel_launch: shape/workspace mismatch: n_in %d in0 %d out %d ws %zu (need %zu); nothing launched\n", n_in, n_in > 0 ? in_sizes[0] : -1, out_size, ws_size, (size_t)WS_END); grid = -1; return; }
        int dev = 0, cus = 0;
        if (hipGetDevice(&dev) != hipSuccess || hipDeviceGetAttribute(&cus, hipDeviceAttributeMultiprocessorCount, dev) != hipSuccess) { fprintf(stderr, "kernel_launch: device query failed\n"); grid = -1; return; }
        if (hipFuncSetAttribute((const void*)enc_fwd, hipFuncAttributeMaxDynamicSharedMemorySize, LDS_BYTES) != hipSuccess) { fprintf(stderr, "kernel_launch: hipFuncSetAttribute failed\n"); grid = -1; return; }
        int per_cu = 0;
        if (hipOccupancyMaxActiveBlocksPerMultiprocessor(&per_cu, (const void*)enc_fwd, NWAVES * 64, LDS_BYTES) != hipSuccess || per_cu < 1)
            fprintf(stderr, "kernel_launch: note: occupancy query reports %d workgroups per CU\n", per_cu);
        (void)hipGetLastError();
        grid = cus;
        if (grid != 256) fprintf(stderr, "kernel_launch: %d CUs; the attention phase assumes 256\n", grid);
    }
    if (grid < 0) return;
    if (hipMemsetAsync((char*)d_ws + WS_CTL, 0, CTL_ZERO_BYTES, stream) != hipSuccess) { fprintf(stderr, "kernel_launch: memset failed\n"); return; }
    Args a{};
    for (int i = 0; i < 22; ++i) a.in[i] = (const float*)d_in[i];
    a.out = (float*)d_out; a.ws = (unsigned char*)d_ws;
#if MK_ONE_LAUNCH
    a.ph_lo = 0; a.ph_hi = N_PHASES;
    hipLaunchKernelGGL(enc_fwd, dim3(grid), dim3(NWAVES * 64), LDS_BYTES, stream, a);
#else
    for (int p = 0; p < N_PHASES; ++p) { a.ph_lo = p; a.ph_hi = p + 1; hipLaunchKernelGGL(enc_fwd, dim3(grid), dim3(NWAVES * 64), LDS_BYTES, stream, a); }
#endif
    const hipError_t le = hipPeekAtLastError();
    if (le != hipSuccess) fprintf(stderr, "kernel_launch: launch failed: %s\n", hipGetErrorName(le));
}
```
